# Optimizing an MI355X kernel written in HIP

```python
import jax, jax.numpy as jnp
from jax import lax
import numpy as np

D_MODEL = 2048
BATCH = 4
SEQ = 4096
DEPTH = 1

D_MIX = D_MODEL
D_POOL = D_MIX // 2
POOL_WINDOWS = (2, 4, 8, 16)
N_POOL_GROUPS = len(POOL_WINDOWS)
POOL_GROUP = D_POOL // N_POOL_GROUPS
D_ATTN = D_MIX - D_POOL
HEAD_DIM = 64
N_Q_HEADS = D_ATTN // HEAD_DIM
N_KV_HEADS = max(1, N_Q_HEADS // 8)
GQA_GROUP = N_Q_HEADS // N_KV_HEADS
WINDOW = 128
D_KV = N_KV_HEADS * HEAD_DIM
D_IN = D_POOL + D_ATTN + 2 * D_KV
N_EXPERT_GROUPS = 8
EXPERTS_PER_GROUP = 8
N_EXPERTS = N_EXPERT_GROUPS * EXPERTS_PER_GROUP
TOP_K = 2
D_EXPERT = D_MODEL // 4
MOE_BLOCK = 128
N_MOD = 6
RMS_EPS = 1e-6
NEG_INF = -1e30

kernel_name = "hymba_pool_swa_sink_hmoe_adaln"


def rmsnorm(x, g):
    xf = x.astype(jnp.float32)
    y = xf * lax.rsqrt(jnp.mean(xf * xf, axis=-1, keepdims=True) + RMS_EPS)
    return (y * g.astype(jnp.float32)).astype(x.dtype)


def modulate(h, shift, scale):
    return h * (1 + scale[:, None, :]) + shift[:, None, :]


def pool_mixer(u, w_pool, pool_scale):
    S = u.shape[1]
    uf = u.astype(jnp.float32)
    cnt_base = jnp.arange(1, S + 1, dtype=jnp.float32)[:, None]
    outs = []
    for gi, w in enumerate(POOL_WINDOWS):
        ug = uf[..., gi * POOL_GROUP:(gi + 1) * POOL_GROUP]
        cs = jnp.cumsum(ug, axis=1)
        lag = jnp.pad(cs, ((0, 0), (w, 0), (0, 0)))[:, :S]
        mean = (cs - lag) / jnp.minimum(cnt_base, w)
        outs.append(jnp.einsum('bsc,cd->bsd', (mean - ug).astype(u.dtype), w_pool[gi]))
    return jnp.concatenate(outs, axis=-1) * pool_scale


def swa_sink_attention(q, k, v, sinks):
    B, S = q.shape[0], q.shape[1]
    nb = S // WINDOW
    qb = q.reshape(B, nb, WINDOW, N_KV_HEADS, GQA_GROUP, HEAD_DIM)
    kb = k.reshape(B, nb, WINDOW, N_KV_HEADS, HEAD_DIM)
    vb = v.reshape(B, nb, WINDOW, N_KV_HEADS, HEAD_DIM)

    def with_prev(t):
        prev = jnp.pad(t, ((0, 0), (1, 0), (0, 0), (0, 0), (0, 0)))[:, :-1]
        return jnp.concatenate([prev, t], axis=2)

    kc, vc = with_prev(kb), with_prev(vb)
    s = jnp.einsum('bnqkgd,bnskd->bnkgqs', qb, kc).astype(jnp.float32) * (HEAD_DIM ** -0.5)
    n = jnp.arange(nb)[:, None, None]
    i = jnp.arange(WINDOW)[None, :, None]
    j = jnp.arange(2 * WINDOW)[None, None, :]
    diff = i - j + WINDOW
    kpos = n * WINDOW + j - WINDOW
    mask = (diff >= 0) & (diff < WINDOW) & (kpos >= 0)
    s = jnp.where(mask[None, :, None, None], s, NEG_INF)
    sink = sinks.astype(jnp.float32).reshape(N_KV_HEADS, GQA_GROUP)[None, None, :, :, None, None]
    m = jnp.maximum(jnp.max(s, axis=-1, keepdims=True), sink)
    p = jnp.exp(s - m)
    p = p / (jnp.sum(p, axis=-1, keepdims=True) + jnp.exp(sink - m))
    o = jnp.einsum('bnkgqs,bnskd->bnqkgd', p.astype(v.dtype), vc)
    return o.reshape(B, S, N_Q_HEADS * HEAD_DIM)


def hierarchical_moe(h, w_rg, b_rg, w_re, b_re, w_gate, w_up, w_down):
    B, S, D = h.shape
    T = B * S
    xt = h.reshape(T, D)
    gl = (xt @ w_rg).astype(jnp.float32) + b_rg.astype(jnp.float32)
    gp = jax.nn.softmax(gl, axis=-1)
    g_sel = jnp.argmax(gl, axis=-1)
    p_grp = jnp.take_along_axis(gp, g_sel[:, None], axis=-1)
    el = ((xt @ w_re).astype(jnp.float32) + b_re.astype(jnp.float32)).reshape(T, N_EXPERT_GROUPS, EXPERTS_PER_GROUP)
    el_sel = jnp.take_along_axis(el, g_sel[:, None, None], axis=1)[:, 0]
    top_l, top_i = lax.top_k(el_sel, TOP_K)
    comb = p_grp * jax.nn.softmax(top_l, axis=-1)
    eid = (g_sel[:, None] * EXPERTS_PER_GROUP + top_i).reshape(-1)
    tok = jnp.repeat(jnp.arange(T, dtype=jnp.int32), TOP_K)
    wts = comb.reshape(-1)
    A = T * TOP_K
    order = jnp.argsort(eid)
    e_s, tok_s, w_s = eid[order], tok[order], wts[order]
    counts = jnp.zeros((N_EXPERTS,), jnp.int32).at[eid].add(1)
    pcounts = (counts + MOE_BLOCK - 1) // MOE_BLOCK * MOE_BLOCK
    starts = jnp.cumsum(counts) - counts
    pends = jnp.cumsum(pcounts)
    pstarts = pends - pcounts
    dest = pstarts[e_s] + jnp.arange(A, dtype=jnp.int32) - starts[e_s]
    P = A + N_EXPERTS * MOE_BLOCK
    nblk = P // MOE_BLOCK
    row_tok = jnp.full((P,), T, jnp.int32).at[dest].set(tok_s)
    row_w = jnp.zeros((P,), jnp.float32).at[dest].set(w_s)
    blk_e = jnp.minimum(jnp.searchsorted(pends, jnp.arange(nblk) * MOE_BLOCK, side='right'), N_EXPERTS - 1)
    xpad = jnp.concatenate([xt, jnp.zeros((1, D), xt.dtype)], axis=0)
    xr = xpad[row_tok].reshape(nblk, MOE_BLOCK, D)

    def expert_block(args):
        xb, e = args
        return (jax.nn.silu(xb @ w_gate[e]) * (xb @ w_up[e])) @ w_down[e]

    yr = lax.map(expert_block, (xr, blk_e)).reshape(P, D)
    yr = yr * row_w[:, None].astype(yr.dtype)
    out = jnp.zeros((T + 1, D), yr.dtype).at[row_tok].add(yr)[:T]
    return out.reshape(B, S, D)


def setup_inputs(seed: int = 0) -> dict:
    key = jax.random.key(seed)
    ks = jax.random.split(key, 20)
    f32 = jnp.float32
    nrm = lambda k, shp, s: jax.random.normal(k, shp, f32) * s
    L = DEPTH
    return {
        "x": nrm(ks[0], (BATCH, SEQ, D_MODEL), 1.0),
        "c": nrm(ks[1], (BATCH, D_MODEL), 1.0),
        "w_ada": nrm(ks[2], (L, D_MODEL, N_MOD * D_MODEL), 0.5 * D_MODEL ** -0.5),
        "b_ada": nrm(ks[3], (L, N_MOD * D_MODEL), 0.02),
        "g_norm1": 1.0 + nrm(ks[4], (L, D_MODEL), 0.02),
        "w_in": nrm(ks[5], (L, D_MODEL, D_IN), D_MODEL ** -0.5),
        "w_pool": nrm(ks[6], (L, N_POOL_GROUPS, POOL_GROUP, POOL_GROUP), POOL_GROUP ** -0.5),
        "pool_scale": 1.0 + nrm(ks[7], (L, D_POOL), 0.1),
        "attn_sinks": nrm(ks[8], (L, N_Q_HEADS), 0.5),
        "w_out": nrm(ks[9], (L, D_MIX, D_MODEL), D_MIX ** -0.5),
        "g_norm2": 1.0 + nrm(ks[10], (L, D_MODEL), 0.02),
        "w_router_group": nrm(ks[11], (L, D_MODEL, N_EXPERT_GROUPS), D_MODEL ** -0.5),
        "b_router_group": nrm(ks[12], (L, N_EXPERT_GROUPS), 0.01),
        "w_router_expert": nrm(ks[13], (L, D_MODEL, N_EXPERTS), D_MODEL ** -0.5),
        "b_router_expert": nrm(ks[14], (L, N_EXPERTS), 0.01),
        "w_gate": nrm(ks[15], (L, N_EXPERTS, D_MODEL, D_EXPERT), D_MODEL ** -0.5),
        "w_up": nrm(ks[16], (L, N_EXPERTS, D_MODEL, D_EXPERT), D_MODEL ** -0.5),
        "w_down": nrm(ks[17], (L, N_EXPERTS, D_EXPERT, D_MODEL), D_EXPERT ** -0.5),
        "g_final": 1.0 + nrm(ks[18], (D_MODEL,), 0.02),
    }


def reference(x, c, w_ada, b_ada, g_norm1, w_in, w_pool, pool_scale, attn_sinks, w_out,
              g_norm2, w_router_group, b_router_group, w_router_expert, b_router_expert,
              w_gate, w_up, w_down, g_final):
    B, S, _ = x.shape
    c_act = jax.nn.silu(c)
    for l in range(DEPTH):
        mod = c_act @ w_ada[l] + b_ada[l]
        sh1, sc1, gt1, sh2, sc2, gt2 = jnp.split(mod, N_MOD, axis=-1)
        h = modulate(rmsnorm(x, g_norm1[l]), sh1, sc1)
        proj = h @ w_in[l]
        u_pool = proj[..., :D_POOL]
        q = proj[..., D_POOL:D_POOL + D_ATTN].reshape(B, S, N_Q_HEADS, HEAD_DIM)
        k = proj[..., D_POOL + D_ATTN:D_POOL + D_ATTN + D_KV].reshape(B, S, N_KV_HEADS, HEAD_DIM)
        v = proj[..., D_POOL + D_ATTN + D_KV:].reshape(B, S, N_KV_HEADS, HEAD_DIM)
        y_pool = pool_mixer(u_pool, w_pool[l], pool_scale[l])
        y_attn = swa_sink_attention(q, k, v, attn_sinks[l])
        mix = jnp.concatenate([y_pool, y_attn], axis=-1)
        x = x + gt1[:, None, :] * (mix @ w_out[l])
        h = modulate(rmsnorm(x, g_norm2[l]), sh2, sc2)
        y = hierarchical_moe(h, w_router_group[l], b_router_group[l], w_router_expert[l],
                             b_router_expert[l], w_gate[l], w_up[l], w_down[l])
        x = x + gt2[:, None, :] * y
    return rmsnorm(x, g_final)
```

```cpp
#include <hip/hip_runtime.h>
#include <cstdio>
#include <cstdint>

#define LAS __attribute__((address_space(3)))
typedef unsigned short bf16_t;
typedef short bf16x8 __attribute__((ext_vector_type(8)));
typedef float f32x4 __attribute__((ext_vector_type(4)));
typedef float f32x16 __attribute__((ext_vector_type(16)));
typedef unsigned u32x4 __attribute__((ext_vector_type(4)));
typedef unsigned u32x2 __attribute__((ext_vector_type(2)));

constexpr int DM = 2048, NB = 4, SEQ = 4096, NT = NB * SEQ;
constexpr int DPOOL = 1024, DIN = 2304, QOFF = 1024, KOFF = 2048, VOFF = 2176;
constexpr int NE = 64, DE = 512, NMOD = 6;
constexpr int PMAX = 2 * NT + NE * 256;
constexpr int MAXMT = PMAX / 256;
constexpr float EPS = 1e-6f;
constexpr int ADA_KS = 32;

constexpr size_t MiB = 1u << 20;
constexpr size_t WS_CTL = 0;
constexpr size_t WS_MOD = 1 * MiB;
constexpr size_t WS_MODP = 2 * MiB;
constexpr size_t WS_WIN = 8 * MiB;
constexpr size_t WS_WOUT = 17 * MiB;
constexpr size_t WS_WPOOL = 25 * MiB;
constexpr size_t WS_WR = 26 * MiB;
constexpr size_t WS_ROUTE = 27 * MiB;
constexpr size_t WS_SSQ = 28 * MiB;
constexpr size_t WS_WGU = 32 * MiB;
constexpr size_t WS_WD = 288 * MiB;
constexpr size_t WS_X1 = 416 * MiB;
constexpr size_t WS_H1 = 544 * MiB;
constexpr size_t WS_PROJ = 608 * MiB;
constexpr size_t WS_D = 680 * MiB;
constexpr size_t WS_Y = 544 * MiB;
constexpr size_t WS_MIX = 736 * MiB;
constexpr size_t WS_H2 = 736 * MiB;
constexpr size_t WS_HID = 802 * MiB;
constexpr size_t WS_END = 850 * MiB;
constexpr size_t RT_TOKE = 0;
constexpr size_t RT_TOKW = 128 * 1024;
constexpr size_t RT_TOKP = 256 * 1024;
constexpr size_t RT_ROWTOK = 384 * 1024;
constexpr size_t RT_TILEE = 640 * 1024;
constexpr size_t RT_PSTART = 644 * 1024;
constexpr size_t RT_NMT = 648 * 1024;
constexpr int CW_COUNTS = 64;
constexpr int CW_CURSOR = 192;

__device__ __forceinline__ unsigned cvt_pk_bf16(float lo, float hi) { unsigned r; asm volatile("v_cvt_pk_bf16_f32 %0, %1, %2" : "=v"(r) : "v"(lo), "v"(hi)); return r; }
__device__ __forceinline__ float bf_lo(unsigned w) { return __uint_as_float(w << 16); }
__device__ __forceinline__ float bf_hi(unsigned w) { return __uint_as_float(w & 0xffff0000u); }
__device__ __forceinline__ float wave_sum(float v) {
#pragma unroll
    for (int o = 1; o < 64; o <<= 1) v += __shfl_xor(v, o);
    return v;
}
__device__ __forceinline__ float fast_silu(float g) { return g * __builtin_amdgcn_rcpf(1.0f + __builtin_amdgcn_exp2f(-1.44269504089f * g)); }

namespace pg8 {
constexpr int BM = 256, BK = 64, HALF = 128, HTB = HALF * BK * 2, STAGE_BYTES = 8 * HTB, NXCD = 8, WGM = 8;
__host__ __device__ __forceinline__ int lds_byte(int r, int c) { const int st = (r >> 4) * 2 + (c >> 5), rr = r & 15, cc = c & 31, ob = rr * 64 + cc * 2; return st * 1024 + (ob ^ (((ob >> 9) & 1) << 5)); }
__host__ __device__ __forceinline__ void stage_rc(int b, int& R, int& C) { const int st = b / 1024, sb = b % 1024, swz = sb ^ (((sb >> 9) & 1) << 5); R = (st >> 1) * 16 + swz / 64; C = (st & 1) * 32 + (swz % 64) / 2; }
__host__ __device__ __forceinline__ int perm32(int rho) { const int n = rho >> 4, i = rho & 15; return 8 * (i >> 2) + 4 * n + (i & 3); }

struct Unit { int pm, pn, e; };

template <int K, class Epi, class Sched, bool ALIGN_EPI, bool SP2>
__device__ __forceinline__ void gemm_phase(LAS unsigned char* lds, const Sched& S, const Epi& E) {
    static_assert(K % 128 == 0 && K >= 256, "K");
    const int tid = threadIdx.x, wid = __builtin_amdgcn_readfirstlane(tid >> 6), lane = tid & 63, wr = wid >> 2, wc = wid & 3, fr = lane & 15, fq = lane >> 4;
    constexpr int nt = K / BK;
    int R0, C0, R1, C1; stage_rc(tid * 16, R0, C0); stage_rc(tid * 16 + 8192, R1, C1);
    const int Rb0 = Epi::PERM ? ((R0 & ~31) + perm32(R0 & 31)) : R0, Rb1 = Epi::PERM ? ((R1 & ~31) + perm32(R1 & 31)) : R1;
    const unsigned ldb2 = (unsigned)S.ldb() * 2u;
    unsigned voffB[2]; voffB[0] = (unsigned)Rb0 * ldb2 + (unsigned)C0 * 2u; voffB[1] = (unsigned)Rb1 * ldb2 + (unsigned)C1 * 2u;
    const size_t hstepB = (size_t)HALF * ldb2;
    constexpr size_t kstep = (size_t)(BK * 2);
    const unsigned ldsw = (unsigned)wid * 1024u;
    const int aoff = lds_byte(wr * 64 + fr, fq * 8), boff = lds_byte(wc * 32 + fr, fq * 8);
#define PG8_SA(b, h) (((b) * 2 + (h)) * HTB)
#define PG8_SB(b, h) ((4 + (b) * 2 + (h)) * HTB)
#define PG8_STAGE2(bufoff, gbase, v0, v1) do { \
        __builtin_amdgcn_global_load_lds((const unsigned*)((const char*)(gbase) + (v0)), (LAS unsigned*)(lds + (bufoff) + ldsw), 16, 0, 0); \
        __builtin_amdgcn_global_load_lds((const unsigned*)((const char*)(gbase) + (v1)), (LAS unsigned*)(lds + (bufoff) + ldsw + 8192), 16, 0, 0); } while (0)
#define PG8_STAGE_B(bufoff, gbase) PG8_STAGE2(bufoff, gbase, voffB[0], voffB[1])
#define PG8_LDA(dst, b, h) do { _Pragma("unroll") for (int m = 0; m < 4; ++m) _Pragma("unroll") for (int k = 0; k < 2; ++k) dst[m][k] = *(const LAS bf16x8*)(lds + PG8_SA(b, h) + aoff + m * 2048 + k * 1024); } while (0)
#define PG8_LDB(dst, b, h) do { _Pragma("unroll") for (int n = 0; n < 2; ++n) _Pragma("unroll") for (int k = 0; k < 2; ++k) dst[n][k] = *(const LAS bf16x8*)(lds + PG8_SB(b, h) + boff + n * 2048 + k * 1024); } while (0)
#define PG8_MMA(ai, bj, At, Bt) do { __builtin_amdgcn_s_setprio(1); _Pragma("unroll") for (int m = 0; m < 4; ++m) _Pragma("unroll") for (int n = 0; n < 2; ++n) _Pragma("unroll") for (int k = 0; k < 2; ++k) \
        acc[ai][bj][m][n] = __builtin_amdgcn_mfma_f32_16x16x32_bf16(Bt[n][k], At[m][k], acc[ai][bj][m][n], 0, 0, 0); __builtin_amdgcn_s_setprio(0); } while (0)
#define PG8_WAIT_V(n) asm volatile("s_waitcnt vmcnt(" #n ")" ::: "memory")
#define PG8_WAIT_L(n) asm volatile("s_waitcnt lgkmcnt(" #n ")" ::: "memory")
#define PG8_BAR __builtin_amdgcn_s_barrier()
#define PG8_SCHED __builtin_amdgcn_sched_barrier(0)
    Unit cur, nxt; int ui = 0;
    if (!S.next(0, cur)) return;
    f32x4 acc[2][2][4][2];
#pragma unroll
    for (int a = 0; a < 2; ++a)
#pragma unroll
        for (int b = 0; b < 2; ++b)
#pragma unroll
            for (int m = 0; m < 4; ++m)
#pragma unroll
                for (int n = 0; n < 2; ++n) acc[a][b][m][n] = (f32x4){0.f, 0.f, 0.f, 0.f};
    bf16x8 At[4][2], B0[2][2], B1[2][2];
    unsigned ca[4], na[4];
    S.a_offs(cur, R0, C0, R1, C1, ca);
    const char* cA = S.a_base(cur); const char* cB = S.b_base(cur);
    if constexpr (SP2) {
        PG8_STAGE_B(PG8_SB(0, 0), cB); PG8_STAGE_B(PG8_SB(0, 1), cB + hstepB); PG8_STAGE2(PG8_SA(0, 0), cA, ca[0], ca[1]); PG8_STAGE2(PG8_SA(0, 1), cA, ca[2], ca[3]);
        if (wr == 1) PG8_BAR;
        PG8_WAIT_V(2); PG8_BAR;
        PG8_STAGE_B(PG8_SB(1, 0), cB + kstep); PG8_STAGE2(PG8_SA(1, 0), cA + kstep, ca[0], ca[1]); PG8_STAGE_B(PG8_SB(1, 1), cB + hstepB + kstep);
        PG8_WAIT_V(6); PG8_BAR;
    } else {
        PG8_STAGE_B(PG8_SB(0, 0), cB); PG8_STAGE2(PG8_SA(0, 0), cA, ca[0], ca[1]); PG8_STAGE_B(PG8_SB(0, 1), cB + hstepB); PG8_STAGE2(PG8_SA(0, 1), cA, ca[2], ca[3]);
        if (wr == 1) PG8_BAR;
        PG8_WAIT_V(4); PG8_BAR;
        PG8_STAGE_B(PG8_SB(1, 0), cB + kstep); PG8_STAGE2(PG8_SA(1, 0), cA + kstep, ca[0], ca[1]); PG8_STAGE_B(PG8_SB(1, 1), cB + hstepB + kstep);
        PG8_WAIT_V(6); PG8_BAR;
    }
    for (;;) {
        const bool has_next = S.next(ui + 1, nxt);
        const char* nA = has_next ? S.a_base(nxt) : cA; const char* nB = has_next ? S.b_base(nxt) : cB;
        if (has_next) S.a_offs(nxt, R0, C0, R1, C1, na); else { na[0] = ca[0]; na[1] = ca[1]; na[2] = ca[2]; na[3] = ca[3]; }
        if constexpr (Sched::GATHER) asm volatile("" : "+v"(na[0]), "+v"(na[1]), "+v"(na[2]), "+v"(na[3]));
#pragma unroll 1
        for (int t = 0; t < nt; t += 2) {
            const bool last = (t == nt - 2);
            const char* a1 = cA + (size_t)(t + 1) * kstep;
            const char* a2 = last ? nA : cA + (size_t)(t + 2) * kstep; const char* b2 = last ? nB : cB + (size_t)(t + 2) * kstep;
            const char* a3 = a2 + kstep; const char* b3 = b2 + kstep;
            unsigned xa[4];
#pragma unroll
            for (int q = 0; q < 4; ++q) xa[q] = last ? na[q] : ca[q];
            if constexpr (SP2) {
            PG8_LDB(B0, 0, 0); PG8_LDB(B1, 0, 1); PG8_SCHED; PG8_LDA(At, 0, 0); PG8_STAGE2(PG8_SA(1, 1), a1, ca[2], ca[3]);
            PG8_WAIT_V(8); PG8_WAIT_L(0); PG8_BAR; PG8_MMA(0, 0, At, B0); PG8_MMA(0, 1, At, B1); PG8_BAR; PG8_SCHED;
            PG8_LDA(At, 0, 1); PG8_STAGE_B(PG8_SB(0, 0), b2); PG8_STAGE_B(PG8_SB(0, 1), b2 + hstepB); PG8_STAGE2(PG8_SA(0, 0), a2, xa[0], xa[1]);
            PG8_WAIT_V(8); PG8_WAIT_L(0); PG8_BAR; PG8_MMA(1, 0, At, B0); PG8_MMA(1, 1, At, B1); PG8_BAR; PG8_SCHED;
            PG8_LDB(B0, 1, 0); PG8_LDB(B1, 1, 1); PG8_SCHED; PG8_LDA(At, 1, 0); PG8_STAGE2(PG8_SA(0, 1), a2, xa[2], xa[3]);
            PG8_WAIT_V(8); PG8_WAIT_L(0); PG8_BAR; PG8_MMA(0, 0, At, B0); PG8_MMA(0, 1, At, B1); PG8_BAR; PG8_SCHED;
            PG8_LDA(At, 1, 1); PG8_STAGE_B(PG8_SB(1, 0), b3); PG8_STAGE_B(PG8_SB(1, 1), b3 + hstepB); PG8_STAGE2(PG8_SA(1, 0), a3, xa[0], xa[1]);
            PG8_WAIT_V(8); PG8_WAIT_L(0); PG8_BAR; PG8_MMA(1, 0, At, B0); PG8_MMA(1, 1, At, B1); PG8_BAR; PG8_SCHED;
            } else {
            PG8_LDB(B0, 0, 0); PG8_SCHED; PG8_LDA(At, 0, 0); PG8_STAGE2(PG8_SA(1, 1), a1, ca[2], ca[3]);
            PG8_WAIT_L(8); PG8_BAR; PG8_WAIT_L(0); PG8_MMA(0, 0, At, B0); PG8_BAR; PG8_SCHED;
            PG8_LDB(B1, 0, 1); PG8_STAGE_B(PG8_SB(0, 0), b2);
            PG8_BAR; PG8_WAIT_L(0); PG8_MMA(0, 1, At, B1); PG8_BAR;
            PG8_LDA(At, 0, 1); PG8_STAGE2(PG8_SA(0, 0), a2, xa[0], xa[1]);
            PG8_BAR; PG8_WAIT_L(0); PG8_MMA(1, 0, At, B0); PG8_BAR; PG8_SCHED;
            PG8_STAGE_B(PG8_SB(0, 1), b2 + hstepB);
            PG8_WAIT_V(6); PG8_BAR; PG8_MMA(1, 1, At, B1); PG8_BAR;
            PG8_LDB(B0, 1, 0); PG8_SCHED; PG8_LDA(At, 1, 0); PG8_STAGE2(PG8_SA(0, 1), a2, xa[2], xa[3]);
            PG8_WAIT_L(8); PG8_BAR; PG8_WAIT_L(0); PG8_MMA(0, 0, At, B0); PG8_BAR; PG8_SCHED;
            PG8_LDB(B1, 1, 1); PG8_STAGE_B(PG8_SB(1, 0), b3);
            PG8_BAR; PG8_WAIT_L(0); PG8_MMA(0, 1, At, B1); PG8_BAR;
            PG8_LDA(At, 1, 1); PG8_STAGE2(PG8_SA(1, 0), a3, xa[0], xa[1]);
            PG8_BAR; PG8_WAIT_L(0); PG8_MMA(1, 0, At, B0); PG8_BAR; PG8_SCHED;
            PG8_STAGE_B(PG8_SB(1, 1), b3 + hstepB);
            PG8_WAIT_V(6); PG8_BAR; PG8_MMA(1, 1, At, B1); PG8_BAR;
            }
        }
        if constexpr (ALIGN_EPI) { if (wr == 0) PG8_BAR; }
        E(acc, cur, wr, wc, fr, fq);
        if (!has_next) break;
#pragma unroll
        for (int a = 0; a < 2; ++a)
#pragma unroll
            for (int b = 0; b < 2; ++b)
#pragma unroll
                for (int m = 0; m < 4; ++m)
#pragma unroll
                    for (int n = 0; n < 2; ++n) acc[a][b][m][n] = (f32x4){0.f, 0.f, 0.f, 0.f};
        cur = nxt; cA = nA; cB = nB; ++ui;
#pragma unroll
        for (int q = 0; q < 4; ++q) ca[q] = na[q];
        if constexpr (ALIGN_EPI) { if (wr == 1) PG8_BAR; }
    }
    PG8_WAIT_V(0);
    if constexpr (!ALIGN_EPI) { if (wr == 0) PG8_BAR; }
    PG8_BAR;
#undef PG8_SA
#undef PG8_SB
#undef PG8_STAGE2
#undef PG8_STAGE_B
#undef PG8_LDA
#undef PG8_LDB
#undef PG8_MMA
#undef PG8_WAIT_V
#undef PG8_WAIT_L
#undef PG8_BAR
#undef PG8_SCHED
}

struct DenseSched {
    static constexpr bool GATHER = false;
    const char* A; const char* Bt; int lda_, ldb_, nM, nN, nwg, G, c;
    __device__ __forceinline__ int ldb() const { return ldb_; }
    __device__ __forceinline__ bool next(int i, Unit& u) const {
        const long L = (long)i * G + c; if (L >= nwg) return false;
        int wgid = (int)L; { const int q = nwg / NXCD, r = nwg % NXCD, xcd = wgid % NXCD, off = wgid / NXCD; wgid = (xcd < r ? xcd * (q + 1) : r * (q + 1) + (xcd - r) * q) + off; }
        const int nig = WGM * nN, gid = wgid / nig, fm = gid * WGM, gsz = (nM - fm) < WGM ? (nM - fm) : WGM;
        u.pm = fm + ((wgid % nig) % gsz); u.pn = (wgid % nig) / gsz; u.e = 0; return true;
    }
    __device__ __forceinline__ const char* a_base(const Unit& u) const { return A + (size_t)u.pm * BM * lda_ * 2; }
    __device__ __forceinline__ const char* b_base(const Unit& u) const { return Bt + (size_t)u.pn * BM * ldb_ * 2; }
    __device__ __forceinline__ void a_offs(const Unit&, int R0, int C0, int R1, int C1, unsigned (&o)[4]) const {
        o[0] = (unsigned)(R0 * lda_ + C0) * 2u; o[1] = (unsigned)(R1 * lda_ + C1) * 2u; o[2] = (unsigned)((R0 + HALF) * lda_ + C0) * 2u; o[3] = (unsigned)((R1 + HALF) * lda_ + C1) * 2u;
    }
};
struct PoolSched {
    static constexpr bool GATHER = false;
    const char* A; const char* Bt; int G, c;
    __device__ __forceinline__ int ldb() const { return 256; }
    __device__ __forceinline__ bool next(int i, Unit& u) const { const int L = i * G + c; if (L >= 256) return false; u.pm = L >> 2; u.pn = L & 3; u.e = 0; return true; }
    __device__ __forceinline__ const char* a_base(const Unit& u) const { return A + ((size_t)u.pm * BM * DPOOL + (size_t)u.pn * 256) * 2; }
    __device__ __forceinline__ const char* b_base(const Unit& u) const { return Bt + (size_t)u.pn * 256 * 256 * 2; }
    __device__ __forceinline__ void a_offs(const Unit&, int R0, int C0, int R1, int C1, unsigned (&o)[4]) const {
        o[0] = (unsigned)(R0 * DPOOL + C0) * 2u; o[1] = (unsigned)(R1 * DPOOL + C1) * 2u; o[2] = (unsigned)((R0 + HALF) * DPOOL + C0) * 2u; o[3] = (unsigned)((R1 + HALF) * DPOOL + C1) * 2u;
    }
};
struct GuSched {
    static constexpr bool GATHER = true;
    const char* H2; const char* W; const int* tile_e; const int* row_tok; int n_units, G, c;
    __device__ __forceinline__ int ldb() const { return DM; }
    __device__ __forceinline__ bool next(int i, Unit& u) const { const int L = i * G + c; if (L >= n_units) return false; u.pm = L >> 2; u.pn = L & 3; u.e = tile_e[u.pm]; return true; }
    __device__ __forceinline__ const char* a_base(const Unit&) const { return H2; }
    __device__ __forceinline__ const char* b_base(const Unit& u) const { return W + ((size_t)u.e * 1024 + (size_t)u.pn * 256) * DM * 2; }
    __device__ __forceinline__ void a_offs(const Unit& u, int R0, int C0, int R1, int C1, unsigned (&o)[4]) const {
        const int* rt = row_tok + u.pm * BM;
        const int t0 = rt[R0], t1 = rt[R1], t2 = rt[R0 + HALF], t3 = rt[R1 + HALF];
        o[0] = (unsigned)(t0 * DM + C0) * 2u; o[1] = (unsigned)(t1 * DM + C1) * 2u; o[2] = (unsigned)(t2 * DM + C0) * 2u; o[3] = (unsigned)(t3 * DM + C1) * 2u;
    }
};
struct DownSched {
    static constexpr bool GATHER = false;
    const char* A; const char* W; const int* tile_e; int n_units, G, c;
    __device__ __forceinline__ int ldb() const { return DE; }
    __device__ __forceinline__ bool next(int i, Unit& u) const { const int L = i * G + c; if (L >= n_units) return false; u.pm = L >> 3; u.pn = L & 7; u.e = tile_e[u.pm]; return true; }
    __device__ __forceinline__ const char* a_base(const Unit& u) const { return A + (size_t)u.pm * BM * DE * 2; }
    __device__ __forceinline__ const char* b_base(const Unit& u) const { return W + ((size_t)u.e * DM + (size_t)u.pn * 256) * DE * 2; }
    __device__ __forceinline__ void a_offs(const Unit&, int R0, int C0, int R1, int C1, unsigned (&o)[4]) const {
        o[0] = (unsigned)(R0 * DE + C0) * 2u; o[1] = (unsigned)(R1 * DE + C1) * 2u; o[2] = (unsigned)((R0 + HALF) * DE + C0) * 2u; o[3] = (unsigned)((R1 + HALF) * DE + C1) * 2u;
    }
};

struct EpiBf16 {
    static constexpr bool PERM = true;
    bf16_t* O; int ldc; const float* cscale;
    __device__ __forceinline__ void operator()(const f32x4 (&acc)[2][2][4][2], const Unit& u, int wr, int wc, int fr, int fq) const {
        const int row0 = u.pm * BM + wr * 64 + fr, col0 = u.pn * BM + wc * 32 + 8 * fq;
#pragma unroll
        for (int bj = 0; bj < 2; ++bj) {
            f32x4 s0 = {1.f, 1.f, 1.f, 1.f}, s1 = s0;
            if (cscale) { s0 = *(const f32x4*)(cscale + col0 + bj * HALF); s1 = *(const f32x4*)(cscale + col0 + bj * HALF + 4); }
#pragma unroll
            for (int ai = 0; ai < 2; ++ai)
#pragma unroll
                for (int m = 0; m < 4; ++m) { bf16_t* rowp = O + (size_t)(row0 + ai * HALF + m * 16) * ldc + col0;
                    const f32x4 v0 = acc[ai][bj][m][0] * s0, v1 = acc[ai][bj][m][1] * s1;
                    u32x4 w; w.x = cvt_pk_bf16(v0[0], v0[1]); w.y = cvt_pk_bf16(v0[2], v0[3]); w.z = cvt_pk_bf16(v1[0], v1[1]); w.w = cvt_pk_bf16(v1[2], v1[3]);
                    *(u32x4*)(rowp + bj * HALF) = w; }
            asm volatile("" ::: "memory");
        }
    }
};
struct EpiOut {
    static constexpr bool PERM = false;
    const float* X; float* X1; const float* mod; float* ssq;
    __device__ __forceinline__ void operator()(const f32x4 (&acc)[2][2][4][2], const Unit& u, int wr, int wc, int fr, int fq) const {
        const int row0 = u.pm * BM + wr * 64 + fr, col0 = u.pn * BM + wc * 32 + 4 * fq;
        const int b = (u.pm * BM) / SEQ;
        const float* gt = mod + (size_t)b * (NMOD * DM) + 2 * DM;
        f32x4 gv[2][2];
#pragma unroll
        for (int bj = 0; bj < 2; ++bj)
#pragma unroll
            for (int n = 0; n < 2; ++n) gv[bj][n] = *(const f32x4*)(gt + col0 + bj * HALF + n * 16);
#pragma unroll
        for (int ai = 0; ai < 2; ++ai)
#pragma unroll
            for (int m = 0; m < 4; ++m) { const int row = row0 + ai * HALF + m * 16; const size_t off = (size_t)row * DM + col0; float s = 0.f;
#pragma unroll
                for (int bj = 0; bj < 2; ++bj)
#pragma unroll
                    for (int n = 0; n < 2; ++n) { const f32x4 xv = *(const f32x4*)(X + off + bj * HALF + n * 16); const f32x4 o = xv + gv[bj][n] * acc[ai][bj][m][n];
                        *(f32x4*)(X1 + off + bj * HALF + n * 16) = o; s += (o[0] * o[0] + o[1] * o[1]) + (o[2] * o[2] + o[3] * o[3]); }
                s += __shfl_xor(s, 16); s += __shfl_xor(s, 32);
                if (fq == 0) ssq[(size_t)row * 32 + u.pn * 4 + wc] = s; }
    }
};
struct EpiGu {
    static constexpr bool PERM = true;
    bf16_t* Hid;
    __device__ __forceinline__ void operator()(const f32x4 (&acc)[2][2][4][2], const Unit& u, int wr, int wc, int fr, int fq) const {
        const int row0 = u.pm * BM + wr * 64 + fr, col0 = u.pn * HALF + wc * 32 + 8 * fq;
#pragma unroll
        for (int ai = 0; ai < 2; ++ai)
#pragma unroll
            for (int m = 0; m < 4; ++m) { bf16_t* rowp = Hid + (size_t)(row0 + ai * HALF + m * 16) * DE + col0;
                const f32x4 g0 = acc[ai][0][m][0], g1 = acc[ai][0][m][1], u0 = acc[ai][1][m][0], u1 = acc[ai][1][m][1];
                float o[8];
#pragma unroll
                for (int j = 0; j < 4; ++j) { o[j] = fast_silu(g0[j]) * u0[j]; o[4 + j] = fast_silu(g1[j]) * u1[j]; }
                u32x4 w; w.x = cvt_pk_bf16(o[0], o[1]); w.y = cvt_pk_bf16(o[2], o[3]); w.z = cvt_pk_bf16(o[4], o[5]); w.w = cvt_pk_bf16(o[6], o[7]);
                *(u32x4*)rowp = w; }
    }
};
}


#define XB_TMO      128
#define XB_XCNT(j)  (256  + 64 * (j))
#define XB_XSUB(j)  (1280 + 64 * (j))
#define XB_XGEN(j)  (2304 + 64 * (j))
#define XB_TOP      3328
#define XB_TOPGEN   3392
#define XCD_BAR_WORDS 3456
#define XB_SPIN_CAP (1u << 18)
__device__ __forceinline__ unsigned xb_ld(unsigned* p)              { return __hip_atomic_load(p, __ATOMIC_RELAXED, __HIP_MEMORY_SCOPE_AGENT); }
__device__ __forceinline__ unsigned xb_add(unsigned* p, unsigned v) { return __hip_atomic_fetch_add(p, v, __ATOMIC_RELAXED, __HIP_MEMORY_SCOPE_AGENT); }
__device__ __forceinline__ unsigned xb_xcc_id() { return (unsigned)__builtin_amdgcn_s_getreg((3 << 11) | 20) & 0xFu; }
#define XB_SPIN(cond, bar) do { unsigned _sp = 0; while (cond) { __builtin_amdgcn_s_sleep(1); \
    if ((++_sp & 255u) == 0u) { if (xb_ld(&(bar)[XB_TMO])) break; if (_sp > XB_SPIN_CAP) { atomicAdd(&(bar)[XB_TMO], 1u); break; } } } } while (0)
struct XcdBarrier { unsigned* bar; unsigned x; volatile LAS unsigned* st; };
__device__ __forceinline__ XcdBarrier xcd_barrier_post(unsigned* bar, volatile LAS unsigned* st) {
    XcdBarrier b; b.bar = bar; b.x = xb_xcc_id(); b.st = st;
    if (threadIdx.x == 0) (void)xb_add(&bar[XB_XCNT(b.x)], 1u);
    return b;
}
__device__ __forceinline__ void xcd_barrier_complete(unsigned* bar, unsigned x, unsigned& nloc, unsigned& nx) {
    const unsigned G = gridDim.x * gridDim.y * gridDim.z;
    unsigned sum, cnt, mine, sp = 0u;
    for (;;) {
        sum = 0u; cnt = 0u; mine = 0u;
#pragma unroll
        for (unsigned j = 0; j < 16; ++j) { const unsigned c = xb_ld(&bar[XB_XCNT(j)]); sum += c; cnt += (c > 0u) ? 1u : 0u; mine = (j == x) ? c : mine; }
        if (sum == G) break;
        __builtin_amdgcn_s_sleep(1);
        if ((++sp & 255u) == 0u) { if (xb_ld(&bar[XB_TMO])) break; if (sp > XB_SPIN_CAP) { atomicAdd(&bar[XB_TMO], 1u); break; } }
    }
    nloc = mine > 0u ? mine : 1u; nx = cnt > 0u ? cnt : 1u;
}
__device__ __forceinline__ void xcd_barrier(const XcdBarrier& b) {
    asm volatile("s_waitcnt vmcnt(0)" ::: "memory");
    __syncthreads();
    if (threadIdx.x == 0) {
        unsigned* bar = b.bar;
        __builtin_amdgcn_s_waitcnt(0);
        unsigned nloc = b.st[0], nx = b.st[1];
        if (nloc == 0u) { xcd_barrier_complete(bar, b.x, nloc, nx); b.st[0] = nloc; b.st[1] = nx; }
        const unsigned old = xb_add(&bar[XB_XSUB(b.x)], 1u);
        const unsigned gen = old / nloc;
        if (old + 1u == (gen + 1u) * nloc) {
            __builtin_amdgcn_fence(__ATOMIC_RELEASE, "agent");
            asm volatile("s_waitcnt vmcnt(0)" ::: "memory");
            const unsigned og = xb_add(&bar[XB_TOP], 1u);
            const unsigned tg = og / nx;
            if (og + 1u == (tg + 1u) * nx) xb_add(&bar[XB_TOPGEN], 1u);
            else XB_SPIN(xb_ld(&bar[XB_TOPGEN]) == tg, bar);
            __builtin_amdgcn_fence(__ATOMIC_ACQUIRE, "agent");
            xb_add(&bar[XB_XGEN(b.x)], 1u);
            asm volatile("s_waitcnt vmcnt(0)" ::: "memory");
        } else {
            XB_SPIN(xb_ld(&bar[XB_XGEN(b.x)]) == gen, bar);
            __builtin_amdgcn_fence(__ATOMIC_ACQUIRE, "agent");
            asm volatile("s_waitcnt vmcnt(0)" ::: "memory");
        }
    }
    __syncthreads();
}
constexpr int CW_BAR = 4096;
constexpr int LDSCTL_OFF = 131072;
constexpr int LDS_PSTART = LDSCTL_OFF + 256, LDS_ADA = LDSCTL_OFF + 1024;

__device__ __forceinline__ void transpose_item(const float* W, int ldw, bf16_t* dst, int ldo, LAS float* scr, int lane) {
#pragma unroll 8
    for (int i = 0; i < 32; ++i) { const int kk = 2 * i + (lane >> 5); scr[kk * 33 + (lane & 31)] = W[(size_t)kk * ldw + (lane & 31)]; }
    asm volatile("s_waitcnt lgkmcnt(0)" ::: "memory");
    const int c = lane & 7;
#pragma unroll
    for (int j = 0; j < 4; ++j) { const int n = (lane >> 3) + 8 * j; const LAS float* s = scr + (8 * c) * 33 + n;
        u32x4 o; o.x = cvt_pk_bf16(s[0 * 33], s[1 * 33]); o.y = cvt_pk_bf16(s[2 * 33], s[3 * 33]); o.z = cvt_pk_bf16(s[4 * 33], s[5 * 33]); o.w = cvt_pk_bf16(s[6 * 33], s[7 * 33]);
        *(u32x4*)(dst + (size_t)n * ldo + 8 * c) = o; }
    asm volatile("s_waitcnt lgkmcnt(0)" ::: "memory");
}

struct Params {
    const float *x, *c, *w_ada, *b_ada, *g1, *w_in, *w_pool, *pool_scale, *sinks, *w_out, *g2, *w_rg, *b_rg, *w_re, *b_re, *w_gate, *w_up, *w_down, *g_final;
    float* out; unsigned char* ws;
};

__device__ __forceinline__ void phase_convert(const Params& p, LAS unsigned char* lds, int gw, int ngw, int lane) {
    LAS float* scr = (LAS float*)(lds + (threadIdx.x >> 6) * 16384);
    bf16_t* Win_t = (bf16_t*)(p.ws + WS_WIN); bf16_t* Wout_t = (bf16_t*)(p.ws + WS_WOUT); bf16_t* Wpool_t = (bf16_t*)(p.ws + WS_WPOOL);
    bf16_t* Wgu_t = (bf16_t*)(p.ws + WS_WGU); bf16_t* Wd_t = (bf16_t*)(p.ws + WS_WD); bf16_t* Wr_t = (bf16_t*)(p.ws + WS_WR);
    constexpr int I_IN = 32 * 72, I_OUT = 32 * 64, I_POOL = 4 * 4 * 8, I_G = NE * 512, I_D = NE * 512;
    constexpr int NITEMS = I_IN + I_OUT + I_POOL + 2 * I_G + I_D;
    for (int it = gw; it < NITEMS; it += ngw) {
        int r = it;
        if (r < I_IN) { const int kb = r / 72, nb = r % 72; transpose_item(p.w_in + (size_t)(64 * kb) * DIN + 32 * nb, DIN, Win_t + (size_t)(32 * nb) * DM + 64 * kb, DM, scr, lane); continue; } r -= I_IN;
        if (r < I_OUT) { const int kb = r / 64, nb = r % 64; transpose_item(p.w_out + (size_t)(64 * kb) * DM + 32 * nb, DM, Wout_t + (size_t)(32 * nb) * DM + 64 * kb, DM, scr, lane); continue; } r -= I_OUT;
        if (r < I_POOL) { const int g = r / 32, q = r % 32, kb = q / 8, nb = q % 8;
            transpose_item(p.w_pool + (size_t)g * 65536 + (size_t)(64 * kb) * 256 + 32 * nb, 256, Wpool_t + (size_t)g * 65536 + (size_t)(32 * nb) * 256 + 64 * kb, 256, scr, lane); continue; } r -= I_POOL;
        if (r < 2 * I_G) { const int up = r >= I_G; if (up) r -= I_G; const int e = r / 512, q = r % 512, kb = q / 16, nb = q % 16; const int n0 = 32 * nb;
            const float* W = (up ? p.w_up : p.w_gate) + (size_t)e * DM * DE + (size_t)(64 * kb) * DE + n0;
            const int drow = (n0 >> 7) * 256 + (n0 & 127) + (up ? 128 : 0);
            transpose_item(W, DE, Wgu_t + ((size_t)e * 1024 + drow) * DM + 64 * kb, DM, scr, lane); continue; } r -= 2 * I_G;
        { const int e = r / 512, q = r % 512, kb = q / 64, nb = q % 64;
          transpose_item(p.w_down + (size_t)e * DE * DM + (size_t)(64 * kb) * DM + 32 * nb, DM, Wd_t + ((size_t)e * DM + 32 * nb) * DE + 64 * kb, DE, scr, lane); }
    }
    const int gt = gw * 64 + lane, ngt = ngw * 64;
    for (int i = gt; i < 80 * DM; i += ngt) { const int n = i / DM, k = i % DM; float v = 0.f; if (n < 8) v = p.w_rg[(size_t)k * 8 + n]; else if (n < 72) v = p.w_re[(size_t)k * 64 + (n - 8)];
        Wr_t[i] = (bf16_t)(cvt_pk_bf16(v, 0.f) & 0xffffu); }
}

__device__ __forceinline__ void phase_ada_partial(const Params& p, LAS unsigned char* lds, int vb) {
    LAS float* sc = (LAS float*)lds;
    const int tid = threadIdx.x; const int g = vb * 512 + tid; const int ks = vb / 6, col4 = g % 3072;
    __syncthreads();
    if (tid < 256) { const int b = tid >> 6, k = tid & 63; const float cv = p.c[b * DM + ks * 64 + k]; sc[tid] = cv / (1.0f + __expf(-cv)); }
    __syncthreads();
    f32x4 a0 = {0, 0, 0, 0}, a1 = a0, a2 = a0, a3 = a0;
    const float* W = p.w_ada + (size_t)(ks * 64) * (NMOD * DM) + col4 * 4;
#pragma unroll 8
    for (int k = 0; k < 64; ++k) { const f32x4 w = *(const f32x4*)(W + (size_t)k * (NMOD * DM)); a0 += w * sc[k]; a1 += w * sc[64 + k]; a2 += w * sc[128 + k]; a3 += w * sc[192 + k]; }
    float* mp = (float*)(p.ws + WS_MODP) + (size_t)ks * 4 * (NMOD * DM) + col4 * 4;
    *(f32x4*)(mp) = a0; *(f32x4*)(mp + NMOD * DM) = a1; *(f32x4*)(mp + 2 * NMOD * DM) = a2; *(f32x4*)(mp + 3 * NMOD * DM) = a3;
}
__device__ __forceinline__ void phase_mod_rest(const Params& p, int gt, int ngt) {
    const float* mp = (const float*)(p.ws + WS_MODP); float* mod = (float*)(p.ws + WS_MOD);
    for (int i = gt; i < 4 * 4 * DM; i += ngt) { const int b = i / (4 * DM), j = 2 * DM + i % (4 * DM); float s = p.b_ada[j];
        for (int ks = 0; ks < ADA_KS; ++ks) s += mp[((size_t)ks * 4 + b) * (NMOD * DM) + j];
        mod[(size_t)b * NMOD * DM + j] = s; }
}
__device__ __forceinline__ void phase_norm1(const Params& p, LAS unsigned char* lds, int lane) {
    const float* mp = (const float*)(p.ws + WS_MODP); bf16_t* h1 = (bf16_t*)(p.ws + WS_H1);
    LAS float* tab = (LAS float*)lds;
    const int tid = threadIdx.x, wave = tid >> 6;
    for (int chunk = blockIdx.x; chunk < NT / 64; chunk += gridDim.x) {
        const int b = chunk >> 6;
        __syncthreads();
        for (int i = tid; i < 2 * DM; i += 512) { float s = p.b_ada[i];
            for (int ks = 0; ks < ADA_KS; ++ks) s += mp[((size_t)ks * 4 + b) * (NMOD * DM) + i];
            tab[i] = s; }
        __syncthreads();
        for (int rr = wave; rr < 64; rr += 8) { const int row = chunk * 64 + rr; const float* xr = p.x + (size_t)row * DM;
            f32x4 v[8]; float s = 0.f;
#pragma unroll
            for (int j = 0; j < 8; ++j) { v[j] = *(const f32x4*)(xr + 4 * lane + 256 * j); s += (v[j][0] * v[j][0] + v[j][1] * v[j][1]) + (v[j][2] * v[j][2] + v[j][3] * v[j][3]); }
            const float rstd = 1.0f / sqrtf(wave_sum(s) * (1.0f / DM) + EPS);
#pragma unroll
            for (int j = 0; j < 8; ++j) { const int c = 4 * lane + 256 * j; const f32x4 g = *(const f32x4*)(p.g1 + c), a = *(const LAS f32x4*)(tab + DM + c), sft = *(const LAS f32x4*)(tab + c);
                const f32x4 o = v[j] * rstd * g * (a + 1.0f) + sft;
                u32x2 w; w.x = cvt_pk_bf16(o[0], o[1]); w.y = cvt_pk_bf16(o[2], o[3]); *(u32x2*)(h1 + (size_t)row * DM + c) = w; } }
    }
}

constexpr int ATT_KP = 144, ATT_VP = 520;
__device__ __forceinline__ void attn_unit(LAS unsigned char* lds, const bf16_t* proj, bf16_t* mix, const float* sinks, int unit) {
    const int tid = threadIdx.x, wid = tid >> 6, lane = tid & 63, l31 = lane & 31, hh = lane >> 5;
    const int kvh = unit & 1, nb = (unit >> 1) & 31, b = unit >> 6;
    const int t0 = b * SEQ + nb * 128;
    LAS unsigned char* Ks = lds; LAS unsigned char* Vt = lds + 256 * ATT_KP;
    __syncthreads();
    for (int c = tid; c < 2048; c += 512) { const int j = c >> 3, ch = c & 7; u32x4 v = {0u, 0u, 0u, 0u};
        if (nb > 0 || j >= 128) v = *(const u32x4*)(proj + (size_t)(t0 - 128 + j) * DIN + KOFF + kvh * 64 + ch * 8);
        *(LAS u32x4*)(Ks + j * ATT_KP + ch * 16) = v; }
    for (int c = tid; c < 1024; c += 512) { const int jp = c & 127, ch = c >> 7; u32x4 v0 = {0u, 0u, 0u, 0u}, v1 = v0;
        if (nb > 0 || jp >= 64) { const bf16_t* vp = proj + (size_t)(t0 - 128 + 2 * jp) * DIN + VOFF + kvh * 64 + ch * 8; v0 = *(const u32x4*)vp; v1 = *(const u32x4*)(vp + DIN); }
#pragma unroll
        for (int e = 0; e < 8; ++e) { const unsigned lo = (v0[e >> 1] >> (16 * (e & 1))) & 0xffffu, hi = (v1[e >> 1] >> (16 * (e & 1))) & 0xffffu;
            *(LAS unsigned*)(Vt + (ch * 8 + e) * ATT_VP + jp * 4) = lo | (hi << 16); } }
    __syncthreads();
    const int hq = kvh * 8 + wid; const float sink2 = sinks[hq] * 1.44269504089f; const float sc2 = 0.125f * 1.44269504089f;
    for (int r = 0; r < 4; ++r) {
        const bf16_t* qp = proj + (size_t)(t0 + 32 * r + l31) * DIN + QOFF + hq * 64 + 8 * hh;
        bf16x8 qf[4];
#pragma unroll
        for (int s = 0; s < 4; ++s) qf[s] = *(const bf16x8*)(qp + 16 * s);
        f32x16 sc[5];
#pragma unroll
        for (int tt = 0; tt < 5; ++tt) { f32x16 a;
#pragma unroll
            for (int i = 0; i < 16; ++i) a[i] = 0.f;
#pragma unroll
            for (int s = 0; s < 4; ++s) { const bf16x8 kf = *(const LAS bf16x8*)(Ks + (32 * (r + tt) + l31) * ATT_KP + (16 * s + 8 * hh) * 2); a = __builtin_amdgcn_mfma_f32_32x32x16_bf16(kf, qf[s], a, 0, 0, 0); }
            sc[tt] = a; }
        float mx = sink2;
#pragma unroll
        for (int tt = 0; tt < 5; ++tt)
#pragma unroll
            for (int i = 0; i < 16; ++i) { const int keyrow = (i & 3) + 8 * (i >> 2) + 4 * hh; bool masked = false;
                if (tt == 0) masked = keyrow <= l31; if (tt == 4) masked = keyrow > l31; if (nb == 0 && r + tt < 4) masked = true;
                const float v = masked ? -1e30f : sc[tt][i] * sc2; sc[tt][i] = v; mx = fmaxf(mx, v); }
        mx = fmaxf(mx, __shfl_xor(mx, 32));
        float sum = 0.f;
#pragma unroll
        for (int tt = 0; tt < 5; ++tt)
#pragma unroll
            for (int i = 0; i < 16; ++i) { const float pv = __builtin_amdgcn_exp2f(sc[tt][i] - mx); sc[tt][i] = pv; sum += pv; }
        sum += __shfl_xor(sum, 32); sum += __builtin_amdgcn_exp2f(sink2 - mx);
        const float inv = 1.0f / sum;
        f32x16 o0, o1;
#pragma unroll
        for (int i = 0; i < 16; ++i) { o0[i] = 0.f; o1[i] = 0.f; }
#pragma unroll
        for (int tt = 0; tt < 5; ++tt)
#pragma unroll
            for (int s2 = 0; s2 < 2; ++s2) {
                u32x4 pw; pw.x = cvt_pk_bf16(sc[tt][8 * s2 + 0], sc[tt][8 * s2 + 1]); pw.y = cvt_pk_bf16(sc[tt][8 * s2 + 2], sc[tt][8 * s2 + 3]);
                pw.z = cvt_pk_bf16(sc[tt][8 * s2 + 4], sc[tt][8 * s2 + 5]); pw.w = cvt_pk_bf16(sc[tt][8 * s2 + 6], sc[tt][8 * s2 + 7]);
                const bf16x8 pb = __builtin_bit_cast(bf16x8, pw);
                const int kb = (32 * (r + tt) + 16 * s2 + 4 * hh) * 2;
                { const u32x2 lo = *(const LAS u32x2*)(Vt + l31 * ATT_VP + kb), hi = *(const LAS u32x2*)(Vt + l31 * ATT_VP + kb + 16);
                  const u32x4 vv = {lo.x, lo.y, hi.x, hi.y}; o0 = __builtin_amdgcn_mfma_f32_32x32x16_bf16(__builtin_bit_cast(bf16x8, vv), pb, o0, 0, 0, 0); }
                { const u32x2 lo = *(const LAS u32x2*)(Vt + (32 + l31) * ATT_VP + kb), hi = *(const LAS u32x2*)(Vt + (32 + l31) * ATT_VP + kb + 16);
                  const u32x4 vv = {lo.x, lo.y, hi.x, hi.y}; o1 = __builtin_amdgcn_mfma_f32_32x32x16_bf16(__builtin_bit_cast(bf16x8, vv), pb, o1, 0, 0, 0); }
            }
        bf16_t* op = mix + (size_t)(t0 + 32 * r + l31) * DM + DPOOL + hq * 64 + 4 * hh;
#pragma unroll
        for (int g = 0; g < 4; ++g) {
            u32x2 w0; w0.x = cvt_pk_bf16(o0[4 * g] * inv, o0[4 * g + 1] * inv); w0.y = cvt_pk_bf16(o0[4 * g + 2] * inv, o0[4 * g + 3] * inv); *(u32x2*)(op + 8 * g) = w0;
            u32x2 w1; w1.x = cvt_pk_bf16(o1[4 * g] * inv, o1[4 * g + 1] * inv); w1.y = cvt_pk_bf16(o1[4 * g + 2] * inv, o1[4 * g + 3] * inv); *(u32x2*)(op + 32 + 8 * g) = w1; }
    }
}

__device__ __forceinline__ void phase_pool_d(const Params& p, int gt, int ngt) {
    const bf16_t* proj = (const bf16_t*)(p.ws + WS_PROJ); bf16_t* d = (bf16_t*)(p.ws + WS_D);
    for (int task = gt; task < NT * 128; task += ngt) {
        const int row = task >> 7, c8 = task & 127, tt = row & (SEQ - 1); const int w = 2 << (c8 >> 5); const int nwin = (tt + 1 < w) ? tt + 1 : w;
        float s[8] = {0, 0, 0, 0, 0, 0, 0, 0}, cur[8] = {0, 0, 0, 0, 0, 0, 0, 0};
        for (int i = 0; i < nwin; ++i) { const u32x4 v = *(const u32x4*)(proj + (size_t)(row - i) * DIN + c8 * 8);
#pragma unroll
            for (int q = 0; q < 4; ++q) { const float a = bf_lo(v[q]), bb = bf_hi(v[q]); s[2 * q] += a; s[2 * q + 1] += bb; if (i == 0) { cur[2 * q] = a; cur[2 * q + 1] = bb; } } }
        const float rn = 1.0f / (float)nwin; u32x4 o;
        o.x = cvt_pk_bf16(s[0] * rn - cur[0], s[1] * rn - cur[1]); o.y = cvt_pk_bf16(s[2] * rn - cur[2], s[3] * rn - cur[3]);
        o.z = cvt_pk_bf16(s[4] * rn - cur[4], s[5] * rn - cur[5]); o.w = cvt_pk_bf16(s[6] * rn - cur[6], s[7] * rn - cur[7]);
        *(u32x4*)(d + (size_t)row * DPOOL + c8 * 8) = o;
    }
}

__device__ __forceinline__ void phase_norm2_router(const Params& p, LAS unsigned char* lds, int gw, int ngw, int lane) {
    const float* mod = (const float*)(p.ws + WS_MOD); const float* x1 = (const float*)(p.ws + WS_X1); const float* ssq = (const float*)(p.ws + WS_SSQ);
    bf16_t* h2 = (bf16_t*)(p.ws + WS_H2); const bf16_t* Wr_t = (const bf16_t*)(p.ws + WS_WR);
    int* tok_e = (int*)(p.ws + WS_ROUTE + RT_TOKE); float* tok_w = (float*)(p.ws + WS_ROUTE + RT_TOKW); unsigned* ctl = (unsigned*)(p.ws + WS_CTL);
    LAS float* lg = (LAS float*)(lds + (threadIdx.x >> 6) * 8192);
    const int fr = lane & 15, fq = lane >> 4;
    if (gw == 0) { *(u32x4*)(h2 + (size_t)NT * DM + lane * 8) = (u32x4){0u, 0u, 0u, 0u}; *(u32x4*)(h2 + (size_t)NT * DM + 512 + lane * 8) = (u32x4){0u, 0u, 0u, 0u};
                   *(u32x4*)(h2 + (size_t)NT * DM + 1024 + lane * 8) = (u32x4){0u, 0u, 0u, 0u}; *(u32x4*)(h2 + (size_t)NT * DM + 1536 + lane * 8) = (u32x4){0u, 0u, 0u, 0u}; }
    for (int grp = gw; grp < NT / 16; grp += ngw) {
        const int r0 = grp * 16, b = r0 / SEQ; const float* sh = mod + (size_t)b * NMOD * DM + 3 * DM; const float* scp = sh + DM;
        for (int rr = 0; rr < 16; ++rr) { const int row = r0 + rr; const float* xr = x1 + (size_t)row * DM;
            float s = ssq[(size_t)row * 32 + (lane & 31)];
#pragma unroll
            for (int o = 1; o < 32; o <<= 1) s += __shfl_xor(s, o);
            const float rstd = 1.0f / sqrtf(s * (1.0f / DM) + EPS);
#pragma unroll
            for (int j = 0; j < 8; ++j) { const int c = 4 * lane + 256 * j; const f32x4 v = *(const f32x4*)(xr + c), g = *(const f32x4*)(p.g2 + c), a = *(const f32x4*)(scp + c), sft = *(const f32x4*)(sh + c);
                const f32x4 o = v * rstd * g * (a + 1.0f) + sft;
                u32x2 w; w.x = cvt_pk_bf16(o[0], o[1]); w.y = cvt_pk_bf16(o[2], o[3]); *(u32x2*)(h2 + (size_t)row * DM + c) = w; } }
        asm volatile("s_waitcnt vmcnt(0)" ::: "memory");
        f32x4 acc[5];
#pragma unroll
        for (int n = 0; n < 5; ++n) acc[n] = (f32x4){0.f, 0.f, 0.f, 0.f};
        const bf16_t* ap = h2 + (size_t)(r0 + fr) * DM + 8 * fq; const bf16_t* bp = Wr_t + (size_t)fr * DM + 8 * fq;
#pragma unroll 4
        for (int k = 0; k < DM; k += 32) { const bf16x8 af = *(const bf16x8*)(ap + k);
#pragma unroll
            for (int n = 0; n < 5; ++n) { const bf16x8 bf = *(const bf16x8*)(bp + (size_t)n * 16 * DM + k); acc[n] = __builtin_amdgcn_mfma_f32_16x16x32_bf16(af, bf, acc[n], 0, 0, 0); } }
#pragma unroll
        for (int n = 0; n < 5; ++n)
#pragma unroll
            for (int j = 0; j < 4; ++j) lg[(4 * fq + j) * 80 + 16 * n + fr] = acc[n][j];
        asm volatile("s_waitcnt lgkmcnt(0)" ::: "memory");
        if (lane < 16) { const LAS float* L = lg + lane * 80; const int row = r0 + lane;
            float gl[8]; float gm = -3.0e38f; int gs = 0;
#pragma unroll
            for (int i = 0; i < 8; ++i) { gl[i] = L[i] + p.b_rg[i]; if (gl[i] > gm) { gm = gl[i]; gs = i; } }
            float den = 0.f;
#pragma unroll
            for (int i = 0; i < 8; ++i) den += __expf(gl[i] - gm);
            const float pg = 1.0f / den;
            float l1 = -3.0e38f, l2 = -3.0e38f; int i1 = 0, i2 = 0;
            for (int i = 0; i < 8; ++i) { const float v = L[8 + gs * 8 + i] + p.b_re[gs * 8 + i];
                if (v > l1) { l2 = l1; i2 = i1; l1 = v; i1 = i; } else if (v > l2) { l2 = v; i2 = i; } }
            const float e2 = __expf(l2 - l1), w1 = pg / (1.0f + e2), w2 = pg * e2 / (1.0f + e2);
            const int ea = gs * 8 + i1, eb = gs * 8 + i2;
            tok_e[2 * row] = ea; tok_e[2 * row + 1] = eb; tok_w[2 * row] = w1; tok_w[2 * row + 1] = w2;
            atomicAdd(&ctl[CW_COUNTS + ea], 1u); atomicAdd(&ctl[CW_COUNTS + eb], 1u); }
        asm volatile("s_waitcnt lgkmcnt(0)" ::: "memory");
    }
}

__device__ __forceinline__ void phase_offsets_assign(const Params& p, LAS unsigned char* lds, int gt, int ngt) {
    unsigned* ctl = (unsigned*)(p.ws + WS_CTL); const int tid = threadIdx.x;
    int* tile_e = (int*)(p.ws + WS_ROUTE + RT_TILEE); int* nmt = (int*)(p.ws + WS_ROUTE + RT_NMT); int* row_tok = (int*)(p.ws + WS_ROUTE + RT_ROWTOK);
    const int* tok_e = (const int*)(p.ws + WS_ROUTE + RT_TOKE); int* tok_p = (int*)(p.ws + WS_ROUTE + RT_TOKP);
    LAS int* ps_l = (LAS int*)(lds + LDS_PSTART);
    if (tid < 64) {
        const int cnt = (int)__hip_atomic_load(&ctl[CW_COUNTS + tid], __ATOMIC_RELAXED, __HIP_MEMORY_SCOPE_AGENT); const int pc = (cnt + 255) / 256 * 256;
        int incl = pc;
#pragma unroll
        for (int o = 1; o < 64; o <<= 1) { const int v = __shfl_up(incl, o); if (tid >= o) incl += v; }
        const int ps = incl - pc; ps_l[tid] = ps;
        if (blockIdx.x == 0) {
            for (int i = 0; i < pc / 256; ++i) tile_e[ps / 256 + i] = tid;
            for (int i = cnt; i < pc; ++i) row_tok[ps + i] = NT;
            if (tid == 63) *nmt = incl / 256;
        }
    }
    __syncthreads();
    for (int a = gt; a < 2 * NT; a += ngt) { const int e = tok_e[a]; const int pos = ps_l[e] + (int)atomicAdd(&ctl[CW_CURSOR + e], 1u); row_tok[pos] = a >> 1; tok_p[a] = pos; }
}

__device__ __forceinline__ void phase_final(const Params& p, int gw, int ngw, int lane) {
    const float* mod = (const float*)(p.ws + WS_MOD); const float* x1 = (const float*)(p.ws + WS_X1); const bf16_t* Y = (const bf16_t*)(p.ws + WS_Y);
    const int* tok_p = (const int*)(p.ws + WS_ROUTE + RT_TOKP); const float* tok_w = (const float*)(p.ws + WS_ROUTE + RT_TOKW);
    for (int row = gw; row < NT; row += ngw) {
        const int b = row / SEQ; const float* gt = mod + (size_t)b * NMOD * DM + 5 * DM; const float* xr = x1 + (size_t)row * DM;
        const int p0 = tok_p[2 * row], p1 = tok_p[2 * row + 1]; const float w0 = tok_w[2 * row], w1 = tok_w[2 * row + 1];
        const bf16_t* y0 = Y + (size_t)p0 * DM; const bf16_t* y1 = Y + (size_t)p1 * DM;
        f32x4 v[8]; float s = 0.f;
#pragma unroll
        for (int j = 0; j < 8; ++j) { const int c = 4 * lane + 256 * j; const f32x4 xv = *(const f32x4*)(xr + c), g = *(const f32x4*)(gt + c);
            const u32x2 a = *(const u32x2*)(y0 + c), bb = *(const u32x2*)(y1 + c);
            f32x4 y; y[0] = w0 * bf_lo(a.x) + w1 * bf_lo(bb.x); y[1] = w0 * bf_hi(a.x) + w1 * bf_hi(bb.x); y[2] = w0 * bf_lo(a.y) + w1 * bf_lo(bb.y); y[3] = w0 * bf_hi(a.y) + w1 * bf_hi(bb.y);
            v[j] = xv + g * y; s += (v[j][0] * v[j][0] + v[j][1] * v[j][1]) + (v[j][2] * v[j][2] + v[j][3] * v[j][3]); }
        const float rstd = 1.0f / sqrtf(wave_sum(s) * (1.0f / DM) + EPS);
#pragma unroll
        for (int j = 0; j < 8; ++j) { const int c = 4 * lane + 256 * j; const f32x4 g = *(const f32x4*)(p.g_final + c); *(f32x4*)(p.out + (size_t)row * DM + c) = v[j] * rstd * g; }
    }
}

constexpr int LDS_BYTES = 147456;
__global__ void __launch_bounds__(512, 2) fwd(Params p) {
    extern __shared__ __attribute__((aligned(16))) unsigned char lds_raw[];
    LAS unsigned char* lds = (LAS unsigned char*)lds_raw;
    const int tid = threadIdx.x, lane = tid & 63, wave = tid >> 6, G = gridDim.x;
    const int gw = blockIdx.x * 8 + wave, ngw = G * 8, gt = blockIdx.x * 512 + tid, ngt = G * 512;
    if (tid < 64) ((LAS unsigned*)(lds + LDSCTL_OFF))[tid] = 0u;
    __syncthreads();
    unsigned* ctl = (unsigned*)(p.ws + WS_CTL);
    const XcdBarrier bar = xcd_barrier_post(ctl + CW_BAR, (volatile LAS unsigned*)(lds + LDSCTL_OFF));

    phase_convert(p, lds, gw, ngw, lane);
    for (int vb = blockIdx.x; vb < 192; vb += G) phase_ada_partial(p, lds + LDS_ADA, vb);
    xcd_barrier(bar);
    phase_mod_rest(p, gt, ngt);
    phase_norm1(p, lds, lane);
    xcd_barrier(bar);
    { pg8::DenseSched S{(const char*)(p.ws + WS_H1), (const char*)(p.ws + WS_WIN), DM, DM, NT / 256, DIN / 256, (NT / 256) * (DIN / 256), G, (int)blockIdx.x};
      pg8::EpiBf16 E{(bf16_t*)(p.ws + WS_PROJ), DIN, nullptr};
      pg8::gemm_phase<DM, pg8::EpiBf16, pg8::DenseSched, true, true>(lds, S, E); }
    xcd_barrier(bar);
    for (int u = blockIdx.x; u < 256; u += G) attn_unit(lds, (const bf16_t*)(p.ws + WS_PROJ), (bf16_t*)(p.ws + WS_MIX), p.sinks, u);
    phase_pool_d(p, gt, ngt);
    xcd_barrier(bar);
    { pg8::PoolSched S{(const char*)(p.ws + WS_D), (const char*)(p.ws + WS_WPOOL), G, (int)blockIdx.x};
      pg8::EpiBf16 E{(bf16_t*)(p.ws + WS_MIX), DM, p.pool_scale};
      pg8::gemm_phase<256, pg8::EpiBf16, pg8::PoolSched, true, true>(lds, S, E); }
    xcd_barrier(bar);
    { pg8::DenseSched S{(const char*)(p.ws + WS_MIX), (const char*)(p.ws + WS_WOUT), DM, DM, NT / 256, DM / 256, (NT / 256) * (DM / 256), G, (int)blockIdx.x};
      pg8::EpiOut E{p.x, (float*)(p.ws + WS_X1), (const float*)(p.ws + WS_MOD), (float*)(p.ws + WS_SSQ)};
      pg8::gemm_phase<DM, pg8::EpiOut, pg8::DenseSched, true, true>(lds, S, E); }
    xcd_barrier(bar);
    phase_norm2_router(p, lds, gw, ngw, lane);
    xcd_barrier(bar);
    phase_offsets_assign(p, lds, gt, ngt);
    xcd_barrier(bar);
    { const int nmt = *(const int*)(p.ws + WS_ROUTE + RT_NMT);
      pg8::GuSched S{(const char*)(p.ws + WS_H2), (const char*)(p.ws + WS_WGU), (const int*)(p.ws + WS_ROUTE + RT_TILEE), (const int*)(p.ws + WS_ROUTE + RT_ROWTOK), nmt * 4, G, (int)blockIdx.x};
      pg8::EpiGu E{(bf16_t*)(p.ws + WS_HID)};
      pg8::gemm_phase<DM, pg8::EpiGu, pg8::GuSched, true, true>(lds, S, E); }
    xcd_barrier(bar);
    { const int nmt = *(const int*)(p.ws + WS_ROUTE + RT_NMT);
      pg8::DownSched S{(const char*)(p.ws + WS_HID), (const char*)(p.ws + WS_WD), (const int*)(p.ws + WS_ROUTE + RT_TILEE), nmt * 8, G, (int)blockIdx.x};
      pg8::EpiBf16 E{(bf16_t*)(p.ws + WS_Y), DM, nullptr};
      pg8::gemm_phase<DE, pg8::EpiBf16, pg8::DownSched, true, true>(lds, S, E); }
    xcd_barrier(bar);
    phase_final(p, gw, ngw, lane);
}

extern "C" void kernel_launch(void* const* d_in, const int* in_sizes, int n_in, void* d_out, int out_size, void* d_ws, size_t ws_size, hipStream_t stream) {
    static int grid = 0;
    if (grid == 0) {
        if (n_in != 19 || in_sizes[0] != NT * DM || out_size != NT * DM || ws_size < WS_END) { fprintf(stderr, "kernel_launch: unexpected shapes (n_in %d, in0 %d, out %d, ws %zu)\n", n_in, n_in > 0 ? in_sizes[0] : -1, out_size, ws_size); grid = -1; return; }
        if (hipFuncSetAttribute((const void*)fwd, hipFuncAttributeMaxDynamicSharedMemorySize, LDS_BYTES) != hipSuccess) { fprintf(stderr, "kernel_launch: hipFuncSetAttribute failed\n"); grid = -1; return; }
        int dev = 0, cus = 0, per_cu = 0;
        if (hipGetDevice(&dev) != hipSuccess || hipDeviceGetAttribute(&cus, hipDeviceAttributeMultiprocessorCount, dev) != hipSuccess) { grid = -1; return; }
        if (hipOccupancyMaxActiveBlocksPerMultiprocessor(&per_cu, (const void*)fwd, 512, LDS_BYTES) != hipSuccess || per_cu < 1) { fprintf(stderr, "kernel_launch: occupancy query says %d blocks per CU\n", per_cu); (void)hipGetLastError(); }
        grid = cus;
    }
    if (grid < 0) return;
    (void)hipMemsetAsync((char*)d_ws + WS_CTL, 0, 1 * MiB, stream);
    Params p{};
    const float** pf = (const float**)&p;
    for (int i = 0; i < 19; ++i) pf[i] = (const float*)d_in[i];
    p.out = (float*)d_out; p.ws = (unsigned char*)d_ws;
    hipLaunchKernelGGL(fwd, dim3(grid), dim3(512), LDS_BYTES, stream, p);
}
```

```cpp
#include <hip/hip_runtime.h>
#include <cstdio>
#include <cstdint>

#define LAS __attribute__((address_space(3)))
typedef unsigned short bf16_t;
typedef short bf16x8 __attribute__((ext_vector_type(8)));
typedef float f32x4 __attribute__((ext_vector_type(4)));
typedef float f32x16 __attribute__((ext_vector_type(16)));
typedef unsigned u32x4 __attribute__((ext_vector_type(4)));
typedef unsigned u32x2 __attribute__((ext_vector_type(2)));

constexpr int DM = 2048, NB = 4, SEQ = 4096, NT = NB * SEQ;
constexpr int DPOOL = 1024, DIN = 2304, QOFF = 1024, KOFF = 2048, VOFF = 2176;
constexpr int NE = 64, DE = 512, NMOD = 6;
constexpr int PMAX = 2 * NT + NE * 256;
constexpr int MAXMT = PMAX / 256;
constexpr float EPS = 1e-6f;
constexpr int ADA_KS = 32;

constexpr size_t MiB = 1u << 20;
constexpr size_t WS_CTL = 0;
constexpr size_t WS_MOD = 1 * MiB;
constexpr size_t WS_MODP = 2 * MiB;
constexpr size_t WS_WIN = 8 * MiB;
constexpr size_t WS_WOUT = 17 * MiB;
constexpr size_t WS_WPOOL = 25 * MiB;
constexpr size_t WS_WR = 26 * MiB;
constexpr size_t WS_ROUTE = 27 * MiB;
constexpr size_t WS_WINNAT = 28 * MiB;
constexpr size_t WS_WGU = 32 * MiB;
constexpr size_t WS_WD = 288 * MiB;
constexpr size_t WS_DELTA = 416 * MiB;
constexpr size_t WS_H1 = 544 * MiB;
constexpr size_t WS_PROJ = 608 * MiB;
constexpr size_t WS_Y = 544 * MiB;
constexpr size_t WS_MIX = 736 * MiB;
constexpr size_t WS_H2 = 736 * MiB;
constexpr size_t WS_HID = 802 * MiB;
constexpr size_t WS_END = 850 * MiB;
constexpr size_t RT_TOKE = 0;
constexpr size_t RT_TOKW = 128 * 1024;
constexpr size_t RT_TOKP = 256 * 1024;
constexpr size_t RT_ROWTOK = 384 * 1024;
constexpr size_t RT_TILEE = 640 * 1024;
constexpr size_t RT_PSTART = 644 * 1024;
constexpr size_t RT_NMT = 648 * 1024;
constexpr int CW_COUNTS = 64;
constexpr int CW_CURSOR = 192;

__device__ __forceinline__ unsigned cvt_pk_bf16(float lo, float hi) { unsigned r; asm volatile("v_cvt_pk_bf16_f32 %0, %1, %2" : "=v"(r) : "v"(lo), "v"(hi)); return r; }
__device__ __forceinline__ float bf_lo(unsigned w) { return __uint_as_float(w << 16); }
__device__ __forceinline__ float bf_hi(unsigned w) { return __uint_as_float(w & 0xffff0000u); }
__device__ __forceinline__ float wave_sum(float v) {
#pragma unroll
    for (int o = 1; o < 64; o <<= 1) v += __shfl_xor(v, o);
    return v;
}
__device__ __forceinline__ float fast_silu(float g) { return g * __builtin_amdgcn_rcpf(1.0f + __builtin_amdgcn_exp2f(-1.44269504089f * g)); }

namespace pg8 {
constexpr int BM = 256, BK = 64, HALF = 128, HTB = HALF * BK * 2, STAGE_BYTES = 8 * HTB, NXCD = 8, WGM = 8;
__host__ __device__ __forceinline__ int lds_byte(int r, int c) { const int st = (r >> 4) * 2 + (c >> 5), rr = r & 15, cc = c & 31, ob = rr * 64 + cc * 2; return st * 1024 + (ob ^ (((ob >> 9) & 1) << 5)); }
__host__ __device__ __forceinline__ void stage_rc(int b, int& R, int& C) { const int st = b / 1024, sb = b % 1024, swz = sb ^ (((sb >> 9) & 1) << 5); R = (st >> 1) * 16 + swz / 64; C = (st & 1) * 32 + (swz % 64) / 2; }
__host__ __device__ __forceinline__ int perm32(int rho) { const int n = rho >> 4, i = rho & 15; return 8 * (i >> 2) + 4 * n + (i & 3); }

struct Unit { int pm, pn, e; };

template <int K, class Epi, class Sched, bool ALIGN_EPI, bool SP2>
__device__ __forceinline__ void gemm_phase(LAS unsigned char* lds, const Sched& S, const Epi& E) {
    static_assert(K % 128 == 0 && K >= 256, "K");
    const int tid = threadIdx.x, wid = __builtin_amdgcn_readfirstlane(tid >> 6), lane = tid & 63, wr = wid >> 2, wc = wid & 3, fr = lane & 15, fq = lane >> 4;
    constexpr int nt = K / BK;
    int R0, C0, R1, C1; stage_rc(tid * 16, R0, C0); stage_rc(tid * 16 + 8192, R1, C1);
    const int Rb0 = Epi::PERM ? ((R0 & ~31) + perm32(R0 & 31)) : R0, Rb1 = Epi::PERM ? ((R1 & ~31) + perm32(R1 & 31)) : R1;
    const unsigned ldb2 = (unsigned)S.ldb() * 2u;
    unsigned voffB[2]; voffB[0] = (unsigned)Rb0 * ldb2 + (unsigned)C0 * 2u; voffB[1] = (unsigned)Rb1 * ldb2 + (unsigned)C1 * 2u;
    const size_t hstepB = (size_t)HALF * ldb2;
    constexpr size_t kstep = (size_t)(BK * 2);
    const unsigned ldsw = (unsigned)wid * 1024u;
    const int aoff = lds_byte(wr * 64 + fr, fq * 8), boff = lds_byte(wc * 32 + fr, fq * 8);
#define PG8_SA(b, h) (((b) * 2 + (h)) * HTB)
#define PG8_SB(b, h) ((4 + (b) * 2 + (h)) * HTB)
#define PG8_STAGE2(bufoff, gbase, v0, v1) do { \
        __builtin_amdgcn_global_load_lds((const unsigned*)((const char*)(gbase) + (v0)), (LAS unsigned*)(lds + (bufoff) + ldsw), 16, 0, 0); \
        __builtin_amdgcn_global_load_lds((const unsigned*)((const char*)(gbase) + (v1)), (LAS unsigned*)(lds + (bufoff) + ldsw + 8192), 16, 0, 0); } while (0)
#define PG8_STAGE_B(bufoff, gbase) PG8_STAGE2(bufoff, gbase, voffB[0], voffB[1])
#define PG8_LDA(dst, b, h) do { _Pragma("unroll") for (int m = 0; m < 4; ++m) _Pragma("unroll") for (int k = 0; k < 2; ++k) dst[m][k] = *(const LAS bf16x8*)(lds + PG8_SA(b, h) + aoff + m * 2048 + k * 1024); } while (0)
#define PG8_LDB(dst, b, h) do { _Pragma("unroll") for (int n = 0; n < 2; ++n) _Pragma("unroll") for (int k = 0; k < 2; ++k) dst[n][k] = *(const LAS bf16x8*)(lds + PG8_SB(b, h) + boff + n * 2048 + k * 1024); } while (0)
#define PG8_MMA(ai, bj, At, Bt) do { __builtin_amdgcn_s_setprio(1); _Pragma("unroll") for (int m = 0; m < 4; ++m) _Pragma("unroll") for (int n = 0; n < 2; ++n) _Pragma("unroll") for (int k = 0; k < 2; ++k) \
        acc[ai][bj][m][n] = __builtin_amdgcn_mfma_f32_16x16x32_bf16(Bt[n][k], At[m][k], acc[ai][bj][m][n], 0, 0, 0); __builtin_amdgcn_s_setprio(0); } while (0)
#define PG8_WAIT_V(n) asm volatile("s_waitcnt vmcnt(" #n ")" ::: "memory")
#define PG8_WAIT_L(n) asm volatile("s_waitcnt lgkmcnt(" #n ")" ::: "memory")
#define PG8_BAR __builtin_amdgcn_s_barrier()
#define PG8_SCHED __builtin_amdgcn_sched_barrier(0)
    Unit cur, nxt; int ui = 0;
    if (!S.next(0, cur)) return;
    f32x4 acc[2][2][4][2];
#pragma unroll
    for (int a = 0; a < 2; ++a)
#pragma unroll
        for (int b = 0; b < 2; ++b)
#pragma unroll
            for (int m = 0; m < 4; ++m)
#pragma unroll
                for (int n = 0; n < 2; ++n) acc[a][b][m][n] = (f32x4){0.f, 0.f, 0.f, 0.f};
    bf16x8 At[4][2], B0[2][2], B1[2][2];
    unsigned ca[4], na[4];
    S.a_offs(cur, R0, C0, R1, C1, ca);
    const char* cA = S.a_base(cur); const char* cB = S.b_base(cur);
    if constexpr (SP2) {
        PG8_STAGE_B(PG8_SB(0, 0), cB); PG8_STAGE_B(PG8_SB(0, 1), cB + hstepB); PG8_STAGE2(PG8_SA(0, 0), cA, ca[0], ca[1]); PG8_STAGE2(PG8_SA(0, 1), cA, ca[2], ca[3]);
        if (wr == 1) PG8_BAR;
        PG8_WAIT_V(2); PG8_BAR;
        PG8_STAGE_B(PG8_SB(1, 0), cB + kstep); PG8_STAGE2(PG8_SA(1, 0), cA + kstep, ca[0], ca[1]); PG8_STAGE_B(PG8_SB(1, 1), cB + hstepB + kstep);
        PG8_WAIT_V(6); PG8_BAR;
    } else {
        PG8_STAGE_B(PG8_SB(0, 0), cB); PG8_STAGE2(PG8_SA(0, 0), cA, ca[0], ca[1]); PG8_STAGE_B(PG8_SB(0, 1), cB + hstepB); PG8_STAGE2(PG8_SA(0, 1), cA, ca[2], ca[3]);
        if (wr == 1) PG8_BAR;
        PG8_WAIT_V(4); PG8_BAR;
        PG8_STAGE_B(PG8_SB(1, 0), cB + kstep); PG8_STAGE2(PG8_SA(1, 0), cA + kstep, ca[0], ca[1]); PG8_STAGE_B(PG8_SB(1, 1), cB + hstepB + kstep);
        PG8_WAIT_V(6); PG8_BAR;
    }
    for (;;) {
        const bool has_next = S.next(ui + 1, nxt);
        const char* nA = has_next ? S.a_base(nxt) : cA; const char* nB = has_next ? S.b_base(nxt) : cB;
        if (has_next) S.a_offs(nxt, R0, C0, R1, C1, na); else { na[0] = ca[0]; na[1] = ca[1]; na[2] = ca[2]; na[3] = ca[3]; }
        if constexpr (Sched::GATHER) asm volatile("" : "+v"(na[0]), "+v"(na[1]), "+v"(na[2]), "+v"(na[3]));
#pragma unroll 1
        for (int t = 0; t < nt; t += 2) {
            const bool last = (t == nt - 2);
            const char* a1 = cA + (size_t)(t + 1) * kstep;
            const char* a2 = last ? nA : cA + (size_t)(t + 2) * kstep; const char* b2 = last ? nB : cB + (size_t)(t + 2) * kstep;
            const char* a3 = a2 + kstep; const char* b3 = b2 + kstep;
            unsigned xa[4];
#pragma unroll
            for (int q = 0; q < 4; ++q) xa[q] = last ? na[q] : ca[q];
            if constexpr (SP2) {
            PG8_LDB(B0, 0, 0); PG8_LDB(B1, 0, 1); PG8_SCHED; PG8_LDA(At, 0, 0); PG8_STAGE2(PG8_SA(1, 1), a1, ca[2], ca[3]);
            PG8_WAIT_V(8); PG8_WAIT_L(0); PG8_BAR; PG8_MMA(0, 0, At, B0); PG8_MMA(0, 1, At, B1); PG8_BAR; PG8_SCHED;
            PG8_LDA(At, 0, 1); PG8_STAGE_B(PG8_SB(0, 0), b2); PG8_STAGE_B(PG8_SB(0, 1), b2 + hstepB); PG8_STAGE2(PG8_SA(0, 0), a2, xa[0], xa[1]);
            PG8_WAIT_V(8); PG8_WAIT_L(0); PG8_BAR; PG8_MMA(1, 0, At, B0); PG8_MMA(1, 1, At, B1); PG8_BAR; PG8_SCHED;
            PG8_LDB(B0, 1, 0); PG8_LDB(B1, 1, 1); PG8_SCHED; PG8_LDA(At, 1, 0); PG8_STAGE2(PG8_SA(0, 1), a2, xa[2], xa[3]);
            PG8_WAIT_V(8); PG8_WAIT_L(0); PG8_BAR; PG8_MMA(0, 0, At, B0); PG8_MMA(0, 1, At, B1); PG8_BAR; PG8_SCHED;
            PG8_LDA(At, 1, 1); PG8_STAGE_B(PG8_SB(1, 0), b3); PG8_STAGE_B(PG8_SB(1, 1), b3 + hstepB); PG8_STAGE2(PG8_SA(1, 0), a3, xa[0], xa[1]);
            PG8_WAIT_V(8); PG8_WAIT_L(0); PG8_BAR; PG8_MMA(1, 0, At, B0); PG8_MMA(1, 1, At, B1); PG8_BAR; PG8_SCHED;
            } else {
            PG8_LDB(B0, 0, 0); PG8_SCHED; PG8_LDA(At, 0, 0); PG8_STAGE2(PG8_SA(1, 1), a1, ca[2], ca[3]);
            PG8_WAIT_L(8); PG8_BAR; PG8_WAIT_L(0); PG8_MMA(0, 0, At, B0); PG8_BAR; PG8_SCHED;
            PG8_LDB(B1, 0, 1); PG8_STAGE_B(PG8_SB(0, 0), b2);
            PG8_BAR; PG8_WAIT_L(0); PG8_MMA(0, 1, At, B1); PG8_BAR;
            PG8_LDA(At, 0, 1); PG8_STAGE2(PG8_SA(0, 0), a2, xa[0], xa[1]);
            PG8_BAR; PG8_WAIT_L(0); PG8_MMA(1, 0, At, B0); PG8_BAR; PG8_SCHED;
            PG8_STAGE_B(PG8_SB(0, 1), b2 + hstepB);
            PG8_WAIT_V(6); PG8_BAR; PG8_MMA(1, 1, At, B1); PG8_BAR;
            PG8_LDB(B0, 1, 0); PG8_SCHED; PG8_LDA(At, 1, 0); PG8_STAGE2(PG8_SA(0, 1), a2, xa[2], xa[3]);
            PG8_WAIT_L(8); PG8_BAR; PG8_WAIT_L(0); PG8_MMA(0, 0, At, B0); PG8_BAR; PG8_SCHED;
            PG8_LDB(B1, 1, 1); PG8_STAGE_B(PG8_SB(1, 0), b3);
            PG8_BAR; PG8_WAIT_L(0); PG8_MMA(0, 1, At, B1); PG8_BAR;
            PG8_LDA(At, 1, 1); PG8_STAGE2(PG8_SA(1, 0), a3, xa[0], xa[1]);
            PG8_BAR; PG8_WAIT_L(0); PG8_MMA(1, 0, At, B0); PG8_BAR; PG8_SCHED;
            PG8_STAGE_B(PG8_SB(1, 1), b3 + hstepB);
            PG8_WAIT_V(6); PG8_BAR; PG8_MMA(1, 1, At, B1); PG8_BAR;
            }
        }
        if constexpr (ALIGN_EPI) { if (wr == 0) PG8_BAR; }
        E(acc, cur, wr, wc, fr, fq);
        if (!has_next) break;
#pragma unroll
        for (int a = 0; a < 2; ++a)
#pragma unroll
            for (int b = 0; b < 2; ++b)
#pragma unroll
                for (int m = 0; m < 4; ++m)
#pragma unroll
                    for (int n = 0; n < 2; ++n) acc[a][b][m][n] = (f32x4){0.f, 0.f, 0.f, 0.f};
        cur = nxt; cA = nA; cB = nB; ++ui;
#pragma unroll
        for (int q = 0; q < 4; ++q) ca[q] = na[q];
        if constexpr (ALIGN_EPI) { if (wr == 1) PG8_BAR; }
    }
    PG8_WAIT_V(0);
    if constexpr (!ALIGN_EPI) { if (wr == 0) PG8_BAR; }
    PG8_BAR;
#undef PG8_SA
#undef PG8_SB
#undef PG8_STAGE2
#undef PG8_STAGE_B
#undef PG8_LDA
#undef PG8_LDB
#undef PG8_MMA
#undef PG8_WAIT_V
#undef PG8_WAIT_L
#undef PG8_BAR
#undef PG8_SCHED
}

struct DenseSched {
    static constexpr bool GATHER = false;
    const char* A; const char* Bt; int lda_, ldb_, nM, nN, nwg, G, c;
    __device__ __forceinline__ int ldb() const { return ldb_; }
    __device__ __forceinline__ bool next(int i, Unit& u) const {
        const long L = (long)i * G + c; if (L >= nwg) return false;
        int wgid = (int)L; { const int q = nwg / NXCD, r = nwg % NXCD, xcd = wgid % NXCD, off = wgid / NXCD; wgid = (xcd < r ? xcd * (q + 1) : r * (q + 1) + (xcd - r) * q) + off; }
        const int nig = WGM * nN, gid = wgid / nig, fm = gid * WGM, gsz = (nM - fm) < WGM ? (nM - fm) : WGM;
        u.pm = fm + ((wgid % nig) % gsz); u.pn = (wgid % nig) / gsz; u.e = 0; return true;
    }
    __device__ __forceinline__ const char* a_base(const Unit& u) const { return A + (size_t)u.pm * BM * lda_ * 2; }
    __device__ __forceinline__ const char* b_base(const Unit& u) const { return Bt + (size_t)u.pn * BM * ldb_ * 2; }
    __device__ __forceinline__ void a_offs(const Unit&, int R0, int C0, int R1, int C1, unsigned (&o)[4]) const {
        o[0] = (unsigned)(R0 * lda_ + C0) * 2u; o[1] = (unsigned)(R1 * lda_ + C1) * 2u; o[2] = (unsigned)((R0 + HALF) * lda_ + C0) * 2u; o[3] = (unsigned)((R1 + HALF) * lda_ + C1) * 2u;
    }
};
struct FoldSched {
    static constexpr bool GATHER = false;
    const char* A; const char* Bt; int G, c;
    __device__ __forceinline__ int ldb() const { return DPOOL; }
    __device__ __forceinline__ bool next(int i, Unit& u) const { const int L = i * G + c; if (L >= 32) return false; u.pm = L >> 3; u.pn = L & 7; u.e = 0; return true; }
    __device__ __forceinline__ const char* a_base(const Unit& u) const { return A + (size_t)u.pm * 256 * 256 * 2; }
    __device__ __forceinline__ const char* b_base(const Unit& u) const { return Bt + ((size_t)u.pn * BM * DPOOL + (size_t)u.pm * 256) * 2; }
    __device__ __forceinline__ void a_offs(const Unit&, int R0, int C0, int R1, int C1, unsigned (&o)[4]) const {
        o[0] = (unsigned)(R0 * 256 + C0) * 2u; o[1] = (unsigned)(R1 * 256 + C1) * 2u; o[2] = (unsigned)((R0 + HALF) * 256 + C0) * 2u; o[3] = (unsigned)((R1 + HALF) * 256 + C1) * 2u;
    }
};
struct GuSched {
    static constexpr bool GATHER = true;
    const char* H2; const char* W; const int* tile_e; const int* row_tok; int n_units, G, c;
    __device__ __forceinline__ int ldb() const { return DM; }
    __device__ __forceinline__ bool next(int i, Unit& u) const { const int L = i * G + c; if (L >= n_units) return false; u.pm = L >> 2; u.pn = L & 3; u.e = tile_e[u.pm]; return true; }
    __device__ __forceinline__ const char* a_base(const Unit&) const { return H2; }
    __device__ __forceinline__ const char* b_base(const Unit& u) const { return W + ((size_t)u.e * 1024 + (size_t)u.pn * 256) * DM * 2; }
    __device__ __forceinline__ void a_offs(const Unit& u, int R0, int C0, int R1, int C1, unsigned (&o)[4]) const {
        const int* rt = row_tok + u.pm * BM;
        const int t0 = rt[R0], t1 = rt[R1], t2 = rt[R0 + HALF], t3 = rt[R1 + HALF];
        o[0] = (unsigned)(t0 * DM + C0) * 2u; o[1] = (unsigned)(t1 * DM + C1) * 2u; o[2] = (unsigned)(t2 * DM + C0) * 2u; o[3] = (unsigned)(t3 * DM + C1) * 2u;
    }
};
struct DownSched {
    static constexpr bool GATHER = false;
    const char* A; const char* W; const int* tile_e; int n_units, G, c;
    __device__ __forceinline__ int ldb() const { return DE; }
    __device__ __forceinline__ bool next(int i, Unit& u) const { const int L = i * G + c; if (L >= n_units) return false; u.pm = L >> 3; u.pn = L & 7; u.e = tile_e[u.pm]; return true; }
    __device__ __forceinline__ const char* a_base(const Unit& u) const { return A + (size_t)u.pm * BM * DE * 2; }
    __device__ __forceinline__ const char* b_base(const Unit& u) const { return W + ((size_t)u.e * DM + (size_t)u.pn * 256) * DE * 2; }
    __device__ __forceinline__ void a_offs(const Unit&, int R0, int C0, int R1, int C1, unsigned (&o)[4]) const {
        o[0] = (unsigned)(R0 * DE + C0) * 2u; o[1] = (unsigned)(R1 * DE + C1) * 2u; o[2] = (unsigned)((R0 + HALF) * DE + C0) * 2u; o[3] = (unsigned)((R1 + HALF) * DE + C1) * 2u;
    }
};

struct EpiBf16 {
    static constexpr bool PERM = true;
    bf16_t* O; int ldc; const float* cscale;
    __device__ __forceinline__ void operator()(const f32x4 (&acc)[2][2][4][2], const Unit& u, int wr, int wc, int fr, int fq) const {
        const int row0 = u.pm * BM + wr * 64 + fr, col0 = u.pn * BM + wc * 32 + 8 * fq;
#pragma unroll
        for (int bj = 0; bj < 2; ++bj) {
            f32x4 s0 = {1.f, 1.f, 1.f, 1.f}, s1 = s0;
            if (cscale) { s0 = *(const f32x4*)(cscale + col0 + bj * HALF); s1 = *(const f32x4*)(cscale + col0 + bj * HALF + 4); }
#pragma unroll
            for (int ai = 0; ai < 2; ++ai)
#pragma unroll
                for (int m = 0; m < 4; ++m) { bf16_t* rowp = O + (size_t)(row0 + ai * HALF + m * 16) * ldc + col0;
                    const f32x4 v0 = acc[ai][bj][m][0] * s0, v1 = acc[ai][bj][m][1] * s1;
                    u32x4 w; w.x = cvt_pk_bf16(v0[0], v0[1]); w.y = cvt_pk_bf16(v0[2], v0[3]); w.z = cvt_pk_bf16(v1[0], v1[1]); w.w = cvt_pk_bf16(v1[2], v1[3]);
                    *(u32x4*)(rowp + bj * HALF) = w; }
            asm volatile("" ::: "memory");
        }
    }
};
struct EpiDelta {
    static constexpr bool PERM = true;
    bf16_t* O; const float* mod;
    __device__ __forceinline__ void operator()(const f32x4 (&acc)[2][2][4][2], const Unit& u, int wr, int wc, int fr, int fq) const {
        const int row0 = u.pm * BM + wr * 64 + fr, col0 = u.pn * BM + wc * 32 + 8 * fq;
        const float* gt = mod + (size_t)((u.pm * BM) / SEQ) * (NMOD * DM) + 2 * DM;
#pragma unroll
        for (int bj = 0; bj < 2; ++bj) {
            const f32x4 s0 = *(const f32x4*)(gt + col0 + bj * HALF), s1 = *(const f32x4*)(gt + col0 + bj * HALF + 4);
#pragma unroll
            for (int ai = 0; ai < 2; ++ai)
#pragma unroll
                for (int m = 0; m < 4; ++m) { bf16_t* rowp = O + (size_t)(row0 + ai * HALF + m * 16) * DM + col0;
                    const f32x4 v0 = acc[ai][bj][m][0] * s0, v1 = acc[ai][bj][m][1] * s1;
                    u32x4 w; w.x = cvt_pk_bf16(v0[0], v0[1]); w.y = cvt_pk_bf16(v0[2], v0[3]); w.z = cvt_pk_bf16(v1[0], v1[1]); w.w = cvt_pk_bf16(v1[2], v1[3]);
                    *(u32x4*)(rowp + bj * HALF) = w; }
            asm volatile("" ::: "memory");
        }
    }
};
struct EpiGu {
    static constexpr bool PERM = true;
    bf16_t* Hid;
    __device__ __forceinline__ void operator()(const f32x4 (&acc)[2][2][4][2], const Unit& u, int wr, int wc, int fr, int fq) const {
        const int row0 = u.pm * BM + wr * 64 + fr, col0 = u.pn * HALF + wc * 32 + 8 * fq;
#pragma unroll
        for (int ai = 0; ai < 2; ++ai)
#pragma unroll
            for (int m = 0; m < 4; ++m) { bf16_t* rowp = Hid + (size_t)(row0 + ai * HALF + m * 16) * DE + col0;
                const f32x4 g0 = acc[ai][0][m][0], g1 = acc[ai][0][m][1], u0 = acc[ai][1][m][0], u1 = acc[ai][1][m][1];
                float o[8];
#pragma unroll
                for (int j = 0; j < 4; ++j) { o[j] = fast_silu(g0[j]) * u0[j]; o[4 + j] = fast_silu(g1[j]) * u1[j]; }
                u32x4 w; w.x = cvt_pk_bf16(o[0], o[1]); w.y = cvt_pk_bf16(o[2], o[3]); w.z = cvt_pk_bf16(o[4], o[5]); w.w = cvt_pk_bf16(o[6], o[7]);
                *(u32x4*)rowp = w; }
    }
};
}


#define XB_TMO      128
#define XB_XCNT(j)  (256  + 64 * (j))
#define XB_XSUB(j)  (1280 + 64 * (j))
#define XB_XGEN(j)  (2304 + 64 * (j))
#define XB_TOP      3328
#define XB_TOPGEN   3392
#define XCD_BAR_WORDS 3456
#define XB_SPIN_CAP (1u << 18)
__device__ __forceinline__ unsigned xb_ld(unsigned* p)              { return __hip_atomic_load(p, __ATOMIC_RELAXED, __HIP_MEMORY_SCOPE_AGENT); }
__device__ __forceinline__ unsigned xb_add(unsigned* p, unsigned v) { return __hip_atomic_fetch_add(p, v, __ATOMIC_RELAXED, __HIP_MEMORY_SCOPE_AGENT); }
__device__ __forceinline__ unsigned xb_xcc_id() { return (unsigned)__builtin_amdgcn_s_getreg((3 << 11) | 20) & 0xFu; }
#define XB_SPIN(cond, bar) do { unsigned _sp = 0; while (cond) { __builtin_amdgcn_s_sleep(1); \
    if ((++_sp & 255u) == 0u) { if (xb_ld(&(bar)[XB_TMO])) break; if (_sp > XB_SPIN_CAP) { atomicAdd(&(bar)[XB_TMO], 1u); break; } } } } while (0)
struct XcdBarrier { unsigned* bar; unsigned x; volatile LAS unsigned* st; };
__device__ __forceinline__ XcdBarrier xcd_barrier_post(unsigned* bar, volatile LAS unsigned* st) {
    XcdBarrier b; b.bar = bar; b.x = xb_xcc_id(); b.st = st;
    if (threadIdx.x == 0) (void)xb_add(&bar[XB_XCNT(b.x)], 1u);
    return b;
}
__device__ __forceinline__ void xcd_barrier_complete(unsigned* bar, unsigned x, unsigned& nloc, unsigned& nx) {
    const unsigned G = gridDim.x * gridDim.y * gridDim.z;
    unsigned sum, cnt, mine, sp = 0u;
    for (;;) {
        sum = 0u; cnt = 0u; mine = 0u;
#pragma unroll
        for (unsigned j = 0; j < 16; ++j) { const unsigned c = xb_ld(&bar[XB_XCNT(j)]); sum += c; cnt += (c > 0u) ? 1u : 0u; mine = (j == x) ? c : mine; }
        if (sum == G) break;
        __builtin_amdgcn_s_sleep(1);
        if ((++sp & 255u) == 0u) { if (xb_ld(&bar[XB_TMO])) break; if (sp > XB_SPIN_CAP) { atomicAdd(&bar[XB_TMO], 1u); break; } }
    }
    nloc = mine > 0u ? mine : 1u; nx = cnt > 0u ? cnt : 1u;
}
__device__ __forceinline__ void xcd_barrier(const XcdBarrier& b) {
    asm volatile("s_waitcnt vmcnt(0)" ::: "memory");
    __syncthreads();
    if (threadIdx.x == 0) {
        unsigned* bar = b.bar;
        __builtin_amdgcn_s_waitcnt(0);
        unsigned nloc = b.st[0], nx = b.st[1];
        if (nloc == 0u) { xcd_barrier_complete(bar, b.x, nloc, nx); b.st[0] = nloc; b.st[1] = nx; }
        const unsigned old = xb_add(&bar[XB_XSUB(b.x)], 1u);
        const unsigned gen = old / nloc;
        if (old + 1u == (gen + 1u) * nloc) {
            __builtin_amdgcn_fence(__ATOMIC_RELEASE, "agent");
            asm volatile("s_waitcnt vmcnt(0)" ::: "memory");
            const unsigned og = xb_add(&bar[XB_TOP], 1u);
            const unsigned tg = og / nx;
            if (og + 1u == (tg + 1u) * nx) xb_add(&bar[XB_TOPGEN], 1u);
            else XB_SPIN(xb_ld(&bar[XB_TOPGEN]) == tg, bar);
            __builtin_amdgcn_fence(__ATOMIC_ACQUIRE, "agent");
            xb_add(&bar[XB_XGEN(b.x)], 1u);
            asm volatile("s_waitcnt vmcnt(0)" ::: "memory");
        } else {
            XB_SPIN(xb_ld(&bar[XB_XGEN(b.x)]) == gen, bar);
            __builtin_amdgcn_fence(__ATOMIC_ACQUIRE, "agent");
            asm volatile("s_waitcnt vmcnt(0)" ::: "memory");
        }
    }
    __syncthreads();
}
constexpr int CW_BAR = 4096;
constexpr int LDSCTL_OFF = 131072;
constexpr int LDS_PSTART = LDSCTL_OFF + 256, LDS_ADA = LDSCTL_OFF + 1024;

__device__ __forceinline__ void transpose_item(const float* W, int ldw, bf16_t* dst, int ldo, int lane) {
    const int c = lane & 7, q = lane >> 3;
    const float* src = W + (size_t)(8 * q) * ldw + 4 * c;
    f32x4 v[8];
#pragma unroll
    for (int j = 0; j < 8; ++j) v[j] = __builtin_nontemporal_load((const f32x4*)(src + (size_t)j * ldw));
#pragma unroll
    for (int i = 0; i < 4; ++i) { u32x4 o; o.x = cvt_pk_bf16(v[0][i], v[1][i]); o.y = cvt_pk_bf16(v[2][i], v[3][i]); o.z = cvt_pk_bf16(v[4][i], v[5][i]); o.w = cvt_pk_bf16(v[6][i], v[7][i]);
        *(u32x4*)(dst + (size_t)(4 * c + i) * ldo + 8 * q) = o; }
}

struct Params {
    const float *x, *c, *w_ada, *b_ada, *g1, *w_in, *w_pool, *pool_scale, *sinks, *w_out, *g2, *w_rg, *b_rg, *w_re, *b_re, *w_gate, *w_up, *w_down, *g_final;
    float* out; unsigned char* ws;
};

__device__ __forceinline__ void phase_convert(const Params& p, int gw, int ngw, int lane) {
    bf16_t* Win_t = (bf16_t*)(p.ws + WS_WIN); bf16_t* Wout_t = (bf16_t*)(p.ws + WS_WOUT); bf16_t* Wpool_t = (bf16_t*)(p.ws + WS_WPOOL);
    bf16_t* Wgu_t = (bf16_t*)(p.ws + WS_WGU); bf16_t* Wd_t = (bf16_t*)(p.ws + WS_WD); bf16_t* Wr_t = (bf16_t*)(p.ws + WS_WR); bf16_t* Win_nat = (bf16_t*)(p.ws + WS_WINNAT);
    constexpr int I_IN = 32 * 40, I_OUT = 32 * 64, I_POOL = 4 * 4 * 8, I_G = NE * 512, I_D = NE * 512;
    constexpr int NITEMS = I_IN + I_OUT + I_POOL + 2 * I_G + I_D;
    for (int it = gw; it < NITEMS; it += ngw) {
        int r = it;
        if (r < I_IN) { const int kb = r / 40, nb = 32 + r % 40; transpose_item(p.w_in + (size_t)(64 * kb) * DIN + 32 * nb, DIN, Win_t + (size_t)(32 * nb) * DM + 64 * kb, DM, lane); continue; } r -= I_IN;
        if (r < I_OUT) { const int kb = r / 64, nb = r % 64; transpose_item(p.w_out + (size_t)(64 * kb) * DM + 32 * nb, DM, Wout_t + (size_t)(32 * nb) * DM + 64 * kb, DM, lane); continue; } r -= I_OUT;
        if (r < I_POOL) { const int g = r / 32, q = r % 32, kb = q / 8, nb = q % 8;
            transpose_item(p.w_pool + (size_t)g * 65536 + (size_t)(64 * kb) * 256 + 32 * nb, 256, Wpool_t + (size_t)g * 65536 + (size_t)(32 * nb) * 256 + 64 * kb, 256, lane); continue; } r -= I_POOL;
        if (r < 2 * I_G) { const int up = r >= I_G; if (up) r -= I_G; const int e = r / 512, q = r % 512, kb = q / 16, nb = q % 16; const int n0 = 32 * nb;
            const float* W = (up ? p.w_up : p.w_gate) + (size_t)e * DM * DE + (size_t)(64 * kb) * DE + n0;
            const int drow = (n0 >> 7) * 256 + (n0 & 127) + (up ? 128 : 0);
            transpose_item(W, DE, Wgu_t + ((size_t)e * 1024 + drow) * DM + 64 * kb, DM, lane); continue; } r -= 2 * I_G;
        { const int e = r / 512, q = r % 512, kb = q / 64, nb = q % 64;
          transpose_item(p.w_down + (size_t)e * DE * DM + (size_t)(64 * kb) * DM + 32 * nb, DM, Wd_t + ((size_t)e * DM + 32 * nb) * DE + 64 * kb, DE, lane); }
    }
    const int gt = gw * 64 + lane, ngt = ngw * 64;
    for (int i = gt; i < DM * DPOOL / 8; i += ngt) { const int k = i >> 7, c8 = i & 127; const f32x4 a = *(const f32x4*)(p.w_in + (size_t)k * DIN + c8 * 8), b = *(const f32x4*)(p.w_in + (size_t)k * DIN + c8 * 8 + 4);
        u32x4 o; o.x = cvt_pk_bf16(a[0], a[1]); o.y = cvt_pk_bf16(a[2], a[3]); o.z = cvt_pk_bf16(b[0], b[1]); o.w = cvt_pk_bf16(b[2], b[3]); *(u32x4*)(Win_nat + (size_t)k * DPOOL + c8 * 8) = o; }
    for (int i = gt; i < 80 * DM; i += ngt) { const int n = i / DM, k = i % DM; float v = 0.f; if (n < 8) v = p.w_rg[(size_t)k * 8 + n]; else if (n < 72) v = p.w_re[(size_t)k * 64 + (n - 8)];
        Wr_t[i] = (bf16_t)(cvt_pk_bf16(v, 0.f) & 0xffffu); }
}

__device__ __forceinline__ void phase_ada_partial(const Params& p, LAS unsigned char* lds, int vb) {
    LAS float* sc = (LAS float*)lds;
    const int tid = threadIdx.x; const int g = vb * 512 + tid; const int ks = vb / 6, col4 = g % 3072;
    __syncthreads();
    if (tid < 256) { const int b = tid >> 6, k = tid & 63; const float cv = p.c[b * DM + ks * 64 + k]; sc[tid] = cv / (1.0f + __expf(-cv)); }
    __syncthreads();
    f32x4 a0 = {0, 0, 0, 0}, a1 = a0, a2 = a0, a3 = a0;
    const float* W = p.w_ada + (size_t)(ks * 64) * (NMOD * DM) + col4 * 4;
#pragma unroll 8
    for (int k = 0; k < 64; ++k) { const f32x4 w = *(const f32x4*)(W + (size_t)k * (NMOD * DM)); a0 += w * sc[k]; a1 += w * sc[64 + k]; a2 += w * sc[128 + k]; a3 += w * sc[192 + k]; }
    float* mp = (float*)(p.ws + WS_MODP) + (size_t)ks * 4 * (NMOD * DM) + col4 * 4;
    *(f32x4*)(mp) = a0; *(f32x4*)(mp + NMOD * DM) = a1; *(f32x4*)(mp + 2 * NMOD * DM) = a2; *(f32x4*)(mp + 3 * NMOD * DM) = a3;
}
__device__ __forceinline__ void phase_mod_rest(const Params& p, int gt, int ngt) {
    const float* mp = (const float*)(p.ws + WS_MODP); float* mod = (float*)(p.ws + WS_MOD);
    for (int i = gt; i < 4 * 4 * DM; i += ngt) { const int b = i / (4 * DM), j = 2 * DM + i % (4 * DM); float s = p.b_ada[j];
        for (int ks = 0; ks < ADA_KS; ++ks) s += mp[((size_t)ks * 4 + b) * (NMOD * DM) + j];
        mod[(size_t)b * NMOD * DM + j] = s; }
}
__device__ __forceinline__ void phase_norm1(const Params& p, LAS unsigned char* lds, int lane) {
    const float* mp = (const float*)(p.ws + WS_MODP); bf16_t* h1 = (bf16_t*)(p.ws + WS_H1);
    LAS float* tab = (LAS float*)lds;
    const int tid = threadIdx.x, wave = tid >> 6;
    for (int chunk = blockIdx.x; chunk < NT / 64; chunk += gridDim.x) {
        const int b = chunk >> 6;
        __syncthreads();
        for (int i = tid; i < 2 * DM; i += 512) { float s = p.b_ada[i];
            for (int ks = 0; ks < ADA_KS; ++ks) s += mp[((size_t)ks * 4 + b) * (NMOD * DM) + i];
            tab[i] = s; }
        __syncthreads();
        for (int rr = wave; rr < 64; rr += 8) { const int row = chunk * 64 + rr; const float* xr = p.x + (size_t)row * DM;
            f32x4 v[8]; float s = 0.f;
#pragma unroll
            for (int j = 0; j < 8; ++j) { v[j] = *(const f32x4*)(xr + 4 * lane + 256 * j); s += (v[j][0] * v[j][0] + v[j][1] * v[j][1]) + (v[j][2] * v[j][2] + v[j][3] * v[j][3]); }
            const float rstd = 1.0f / sqrtf(wave_sum(s) * (1.0f / DM) + EPS);
#pragma unroll
            for (int j = 0; j < 8; ++j) { const int c = 4 * lane + 256 * j; const f32x4 g = *(const f32x4*)(p.g1 + c), a = *(const LAS f32x4*)(tab + DM + c), sft = *(const LAS f32x4*)(tab + c);
                const f32x4 o = v[j] * rstd * g * (a + 1.0f) + sft;
                u32x2 w; w.x = cvt_pk_bf16(o[0], o[1]); w.y = cvt_pk_bf16(o[2], o[3]); *(u32x2*)(h1 + (size_t)row * DM + c) = w; } }
    }
}

constexpr int ATT_KP = 144, ATT_VP = 520;
__device__ __forceinline__ void attn_unit(LAS unsigned char* lds, const bf16_t* proj, bf16_t* mix, const float* sinks, int unit) {
    const int tid = threadIdx.x, wid = tid >> 6, lane = tid & 63, l31 = lane & 31, hh = lane >> 5;
    const int kvh = unit & 1, nb = (unit >> 1) & 31, b = unit >> 6;
    const int t0 = b * SEQ + nb * 128;
    LAS unsigned char* Ks = lds; LAS unsigned char* Vt = lds + 256 * ATT_KP;
    __syncthreads();
    for (int c = tid; c < 2048; c += 512) { const int j = c >> 3, ch = c & 7; u32x4 v = {0u, 0u, 0u, 0u};
        if (nb > 0 || j >= 128) v = *(const u32x4*)(proj + (size_t)(t0 - 128 + j) * DIN + KOFF + kvh * 64 + ch * 8);
        *(LAS u32x4*)(Ks + j * ATT_KP + ch * 16) = v; }
    for (int c = tid; c < 1024; c += 512) { const int jp = c & 127, ch = c >> 7; u32x4 v0 = {0u, 0u, 0u, 0u}, v1 = v0;
        if (nb > 0 || jp >= 64) { const bf16_t* vp = proj + (size_t)(t0 - 128 + 2 * jp) * DIN + VOFF + kvh * 64 + ch * 8; v0 = *(const u32x4*)vp; v1 = *(const u32x4*)(vp + DIN); }
#pragma unroll
        for (int e = 0; e < 8; ++e) { const unsigned lo = (v0[e >> 1] >> (16 * (e & 1))) & 0xffffu, hi = (v1[e >> 1] >> (16 * (e & 1))) & 0xffffu;
            *(LAS unsigned*)(Vt + (ch * 8 + e) * ATT_VP + jp * 4) = lo | (hi << 16); } }
    __syncthreads();
    const int hq = kvh * 8 + wid; const float sink2 = sinks[hq] * 1.44269504089f; const float sc2 = 0.125f * 1.44269504089f;
    for (int r = 0; r < 4; ++r) {
        const bf16_t* qp = proj + (size_t)(t0 + 32 * r + l31) * DIN + QOFF + hq * 64 + 8 * hh;
        bf16x8 qf[4];
#pragma unroll
        for (int s = 0; s < 4; ++s) qf[s] = *(const bf16x8*)(qp + 16 * s);
        f32x16 sc[5];
#pragma unroll
        for (int tt = 0; tt < 5; ++tt) { f32x16 a;
#pragma unroll
            for (int i = 0; i < 16; ++i) a[i] = 0.f;
#pragma unroll
            for (int s = 0; s < 4; ++s) { const bf16x8 kf = *(const LAS bf16x8*)(Ks + (32 * (r + tt) + l31) * ATT_KP + (16 * s + 8 * hh) * 2); a = __builtin_amdgcn_mfma_f32_32x32x16_bf16(kf, qf[s], a, 0, 0, 0); }
            sc[tt] = a; }
        float mx = sink2;
#pragma unroll
        for (int tt = 0; tt < 5; ++tt)
#pragma unroll
            for (int i = 0; i < 16; ++i) { const int keyrow = (i & 3) + 8 * (i >> 2) + 4 * hh; bool masked = false;
                if (tt == 0) masked = keyrow <= l31; if (tt == 4) masked = keyrow > l31; if (nb == 0 && r + tt < 4) masked = true;
                const float v = masked ? -1e30f : sc[tt][i] * sc2; sc[tt][i] = v; mx = fmaxf(mx, v); }
        mx = fmaxf(mx, __shfl_xor(mx, 32));
        float sum = 0.f;
#pragma unroll
        for (int tt = 0; tt < 5; ++tt)
#pragma unroll
            for (int i = 0; i < 16; ++i) { const float pv = __builtin_amdgcn_exp2f(sc[tt][i] - mx); sc[tt][i] = pv; sum += pv; }
        sum += __shfl_xor(sum, 32); sum += __builtin_amdgcn_exp2f(sink2 - mx);
        const float inv = 1.0f / sum;
        f32x16 o0, o1;
#pragma unroll
        for (int i = 0; i < 16; ++i) { o0[i] = 0.f; o1[i] = 0.f; }
#pragma unroll
        for (int tt = 0; tt < 5; ++tt)
#pragma unroll
            for (int s2 = 0; s2 < 2; ++s2) {
                u32x4 pw; pw.x = cvt_pk_bf16(sc[tt][8 * s2 + 0], sc[tt][8 * s2 + 1]); pw.y = cvt_pk_bf16(sc[tt][8 * s2 + 2], sc[tt][8 * s2 + 3]);
                pw.z = cvt_pk_bf16(sc[tt][8 * s2 + 4], sc[tt][8 * s2 + 5]); pw.w = cvt_pk_bf16(sc[tt][8 * s2 + 6], sc[tt][8 * s2 + 7]);
                const bf16x8 pb = __builtin_bit_cast(bf16x8, pw);
                const int kb = (32 * (r + tt) + 16 * s2 + 4 * hh) * 2;
                { const u32x2 lo = *(const LAS u32x2*)(Vt + l31 * ATT_VP + kb), hi = *(const LAS u32x2*)(Vt + l31 * ATT_VP + kb + 16);
                  const u32x4 vv = {lo.x, lo.y, hi.x, hi.y}; o0 = __builtin_amdgcn_mfma_f32_32x32x16_bf16(__builtin_bit_cast(bf16x8, vv), pb, o0, 0, 0, 0); }
                { const u32x2 lo = *(const LAS u32x2*)(Vt + (32 + l31) * ATT_VP + kb), hi = *(const LAS u32x2*)(Vt + (32 + l31) * ATT_VP + kb + 16);
                  const u32x4 vv = {lo.x, lo.y, hi.x, hi.y}; o1 = __builtin_amdgcn_mfma_f32_32x32x16_bf16(__builtin_bit_cast(bf16x8, vv), pb, o1, 0, 0, 0); }
            }
        bf16_t* op = mix + (size_t)(t0 + 32 * r + l31) * DM + DPOOL + hq * 64 + 4 * hh;
#pragma unroll
        for (int g = 0; g < 4; ++g) {
            u32x2 w0; w0.x = cvt_pk_bf16(o0[4 * g] * inv, o0[4 * g + 1] * inv); w0.y = cvt_pk_bf16(o0[4 * g + 2] * inv, o0[4 * g + 3] * inv); *(u32x2*)(op + 8 * g) = w0;
            u32x2 w1; w1.x = cvt_pk_bf16(o1[4 * g] * inv, o1[4 * g + 1] * inv); w1.y = cvt_pk_bf16(o1[4 * g + 2] * inv, o1[4 * g + 3] * inv); *(u32x2*)(op + 32 + 8 * g) = w1; }
    }
}

__device__ __forceinline__ void phase_pool_win(const Params& p, int gt, int ngt) {
    const bf16_t* proj = (const bf16_t*)(p.ws + WS_PROJ); bf16_t* mix = (bf16_t*)(p.ws + WS_MIX);
    for (int task = gt; task < (NT / 16) * 128; task += ngt) {
        const int r0 = (task >> 7) * 16, c8 = task & 127, tt0 = r0 & (SEQ - 1); const int w = 2 << (c8 >> 5);
        const bf16_t* zp = proj + (size_t)r0 * DIN + c8 * 8;
        const f32x4 sa = *(const f32x4*)(p.pool_scale + c8 * 8), sb = *(const f32x4*)(p.pool_scale + c8 * 8 + 4);
        float s[8] = {0, 0, 0, 0, 0, 0, 0, 0};
        for (int i = 1; i < w; ++i) if (tt0 - i >= 0) { const u32x4 v = *(const u32x4*)(zp - (ptrdiff_t)i * DIN);
#pragma unroll
            for (int q = 0; q < 4; ++q) { s[2 * q] += bf_lo(v[q]); s[2 * q + 1] += bf_hi(v[q]); } }
        for (int t = 0; t < 16; ++t) {
            const u32x4 v = *(const u32x4*)(zp + (size_t)t * DIN); float cur[8];
#pragma unroll
            for (int q = 0; q < 4; ++q) { cur[2 * q] = bf_lo(v[q]); cur[2 * q + 1] = bf_hi(v[q]); s[2 * q] += cur[2 * q]; s[2 * q + 1] += cur[2 * q + 1]; }
            const int nwin = (tt0 + t + 1 < w) ? tt0 + t + 1 : w; const float rn = 1.0f / (float)nwin;
            u32x4 o; o.x = cvt_pk_bf16((s[0] * rn - cur[0]) * sa[0], (s[1] * rn - cur[1]) * sa[1]); o.y = cvt_pk_bf16((s[2] * rn - cur[2]) * sa[2], (s[3] * rn - cur[3]) * sa[3]);
            o.z = cvt_pk_bf16((s[4] * rn - cur[4]) * sb[0], (s[5] * rn - cur[5]) * sb[1]); o.w = cvt_pk_bf16((s[6] * rn - cur[6]) * sb[2], (s[7] * rn - cur[7]) * sb[3]);
            *(u32x4*)(mix + (size_t)(r0 + t) * DM + c8 * 8) = o;
            if (tt0 + t - (w - 1) >= 0) { const u32x4 ov = *(const u32x4*)(zp + (ptrdiff_t)(t - (w - 1)) * DIN);
#pragma unroll
                for (int q = 0; q < 4; ++q) { s[2 * q] -= bf_lo(ov[q]); s[2 * q + 1] -= bf_hi(ov[q]); } }
        }
    }
}

__device__ __forceinline__ void phase_norm2_router(const Params& p, LAS unsigned char* lds, int lane, bool do_count = true) {
    const float* mod = (const float*)(p.ws + WS_MOD); const bf16_t* delta = (const bf16_t*)(p.ws + WS_DELTA);
    bf16_t* h2 = (bf16_t*)(p.ws + WS_H2); const bf16_t* Wr_t = (const bf16_t*)(p.ws + WS_WR);
    int* tok_e = (int*)(p.ws + WS_ROUTE + RT_TOKE); float* tok_w = (float*)(p.ws + WS_ROUTE + RT_TOKW); unsigned* ctl = (unsigned*)(p.ws + WS_CTL);
    LAS float* tab = (LAS float*)lds;
    LAS float* plog = (LAS float*)(lds + 16384);
    const int tid = threadIdx.x, wave = tid >> 6, fr = lane & 15, fq = lane >> 4;
    if (blockIdx.x == 0 && tid < 256) *(u32x4*)(h2 + (size_t)NT * DM + tid * 8) = (u32x4){0u, 0u, 0u, 0u};
    for (int chunk = blockIdx.x; chunk < NT / 64; chunk += gridDim.x) {
        const int b = chunk >> 6; const float* sh = mod + (size_t)b * NMOD * DM + 3 * DM; const float* scp = sh + DM;
        __syncthreads();
        for (int i = tid; i < DM; i += 512) { tab[i] = p.g2[i] * (1.0f + scp[i]); tab[DM + i] = sh[i]; }
        __syncthreads();
        for (int rr = wave * 8; rr < wave * 8 + 8; ++rr) { const int row = chunk * 64 + rr; const float* xr = p.x + (size_t)row * DM; const bf16_t* dr = delta + (size_t)row * DM;
            f32x4 v[8]; float s = 0.f;
#pragma unroll
            for (int j = 0; j < 8; ++j) { const int c = 4 * lane + 256 * j; const f32x4 xv = *(const f32x4*)(xr + c); const u32x2 dv = *(const u32x2*)(dr + c);
                v[j][0] = xv[0] + bf_lo(dv.x); v[j][1] = xv[1] + bf_hi(dv.x); v[j][2] = xv[2] + bf_lo(dv.y); v[j][3] = xv[3] + bf_hi(dv.y);
                s += (v[j][0] * v[j][0] + v[j][1] * v[j][1]) + (v[j][2] * v[j][2] + v[j][3] * v[j][3]); }
            const float rstd = 1.0f / sqrtf(wave_sum(s) * (1.0f / DM) + EPS);
#pragma unroll
            for (int j = 0; j < 8; ++j) { const int c = 4 * lane + 256 * j; const f32x4 g = *(const LAS f32x4*)(tab + c), sft = *(const LAS f32x4*)(tab + DM + c);
                const f32x4 o = v[j] * rstd * g + sft;
                u32x2 w; w.x = cvt_pk_bf16(o[0], o[1]); w.y = cvt_pk_bf16(o[2], o[3]); *(u32x2*)(h2 + (size_t)row * DM + c) = w; } }
        asm volatile("s_waitcnt vmcnt(0)" ::: "memory");
        __syncthreads();
        { const int g = wave & 3, kh = wave >> 2; const int r0 = chunk * 64 + 16 * g;
          f32x4 acc[5];
#pragma unroll
          for (int n = 0; n < 5; ++n) acc[n] = (f32x4){0.f, 0.f, 0.f, 0.f};
          const bf16_t* ap = h2 + (size_t)(r0 + fr) * DM + kh * 1024 + 8 * fq; const bf16_t* bp = Wr_t + (size_t)fr * DM + kh * 1024 + 8 * fq;
#pragma unroll 4
          for (int k = 0; k < 1024; k += 32) { const bf16x8 af = *(const bf16x8*)(ap + k);
#pragma unroll
              for (int n = 0; n < 5; ++n) { const bf16x8 bf = *(const bf16x8*)(bp + (size_t)n * 16 * DM + k); acc[n] = __builtin_amdgcn_mfma_f32_16x16x32_bf16(af, bf, acc[n], 0, 0, 0); } }
          LAS float* lg = plog + wave * (16 * 80);
#pragma unroll
          for (int n = 0; n < 5; ++n)
#pragma unroll
              for (int j = 0; j < 4; ++j) lg[(4 * fq + j) * 80 + 16 * n + fr] = acc[n][j]; }
        __syncthreads();
        if (tid < 64) { const int g = tid >> 4, r = tid & 15; const LAS float* L0 = plog + g * (16 * 80) + r * 80; const LAS float* L1 = L0 + 4 * (16 * 80); const int row = chunk * 64 + tid;
            float gl[8]; float gm = -3.0e38f; int gs = 0;
#pragma unroll
            for (int i = 0; i < 8; ++i) { gl[i] = (L0[i] + L1[i]) + p.b_rg[i]; if (gl[i] > gm) { gm = gl[i]; gs = i; } }
            float den = 0.f;
#pragma unroll
            for (int i = 0; i < 8; ++i) den += __expf(gl[i] - gm);
            const float pg = 1.0f / den;
            float l1 = -3.0e38f, l2 = -3.0e38f; int i1 = 0, i2 = 0;
            for (int i = 0; i < 8; ++i) { const float v = (L0[8 + gs * 8 + i] + L1[8 + gs * 8 + i]) + p.b_re[gs * 8 + i];
                if (v > l1) { l2 = l1; i2 = i1; l1 = v; i1 = i; } else if (v > l2) { l2 = v; i2 = i; } }
            const float e2 = __expf(l2 - l1), w1 = pg / (1.0f + e2), w2 = pg * e2 / (1.0f + e2);
            const int ea = gs * 8 + i1, eb = gs * 8 + i2;
            tok_e[2 * row] = ea; tok_e[2 * row + 1] = eb; tok_w[2 * row] = w1; tok_w[2 * row + 1] = w2;
            if (do_count) { atomicAdd(&ctl[CW_COUNTS + ea], 1u); atomicAdd(&ctl[CW_COUNTS + eb], 1u); } }
    }
}

__device__ __forceinline__ void phase_offsets_assign(const Params& p, LAS unsigned char* lds, int gt, int ngt) {
    unsigned* ctl = (unsigned*)(p.ws + WS_CTL); const int tid = threadIdx.x;
    int* tile_e = (int*)(p.ws + WS_ROUTE + RT_TILEE); int* nmt = (int*)(p.ws + WS_ROUTE + RT_NMT); int* row_tok = (int*)(p.ws + WS_ROUTE + RT_ROWTOK);
    const int* tok_e = (const int*)(p.ws + WS_ROUTE + RT_TOKE); int* tok_p = (int*)(p.ws + WS_ROUTE + RT_TOKP);
    LAS int* ps_l = (LAS int*)(lds + LDS_PSTART);
    if (tid < 64) {
        const int cnt = (int)__hip_atomic_load(&ctl[CW_COUNTS + tid], __ATOMIC_RELAXED, __HIP_MEMORY_SCOPE_AGENT); const int pc = (cnt + 255) / 256 * 256;
        int incl = pc;
#pragma unroll
        for (int o = 1; o < 64; o <<= 1) { const int v = __shfl_up(incl, o); if (tid >= o) incl += v; }
        const int ps = incl - pc; ps_l[tid] = ps;
        if (blockIdx.x == 0) {
            for (int i = 0; i < pc / 256; ++i) tile_e[ps / 256 + i] = tid;
            for (int i = cnt; i < pc; ++i) row_tok[ps + i] = NT;
            if (tid == 63) *nmt = incl / 256;
        }
    }
    __syncthreads();
    for (int a = gt; a < 2 * NT; a += ngt) { const int e = tok_e[a]; const int pos = ps_l[e] + (int)atomicAdd(&ctl[CW_CURSOR + e], 1u); row_tok[pos] = a >> 1; tok_p[a] = pos; }
}

__device__ __forceinline__ void phase_final(const Params& p, int gw, int ngw, int lane) {
    const float* mod = (const float*)(p.ws + WS_MOD); const bf16_t* delta = (const bf16_t*)(p.ws + WS_DELTA); const bf16_t* Y = (const bf16_t*)(p.ws + WS_Y);
    const int* tok_p = (const int*)(p.ws + WS_ROUTE + RT_TOKP); const float* tok_w = (const float*)(p.ws + WS_ROUTE + RT_TOKW);
    for (int row = gw; row < NT; row += ngw) {
        const int b = row / SEQ; const float* gt = mod + (size_t)b * NMOD * DM + 5 * DM; const float* xr = p.x + (size_t)row * DM; const bf16_t* dr = delta + (size_t)row * DM;
        const int p0 = tok_p[2 * row], p1 = tok_p[2 * row + 1]; const float w0 = tok_w[2 * row], w1 = tok_w[2 * row + 1];
        const bf16_t* y0 = Y + (size_t)p0 * DM; const bf16_t* y1 = Y + (size_t)p1 * DM;
        f32x4 v[8]; float s = 0.f;
#pragma unroll
        for (int j = 0; j < 8; ++j) { const int c = 4 * lane + 256 * j; const f32x4 xv = *(const f32x4*)(xr + c), g = *(const f32x4*)(gt + c);
            const u32x2 a = *(const u32x2*)(y0 + c), bb = *(const u32x2*)(y1 + c), dv = *(const u32x2*)(dr + c);
            const f32x4 xv1 = {xv[0] + bf_lo(dv.x), xv[1] + bf_hi(dv.x), xv[2] + bf_lo(dv.y), xv[3] + bf_hi(dv.y)};
            f32x4 y; y[0] = w0 * bf_lo(a.x) + w1 * bf_lo(bb.x); y[1] = w0 * bf_hi(a.x) + w1 * bf_hi(bb.x); y[2] = w0 * bf_lo(a.y) + w1 * bf_lo(bb.y); y[3] = w0 * bf_hi(a.y) + w1 * bf_hi(bb.y);
            v[j] = xv1 + g * y; s += (v[j][0] * v[j][0] + v[j][1] * v[j][1]) + (v[j][2] * v[j][2] + v[j][3] * v[j][3]); }
        const float rstd = 1.0f / sqrtf(wave_sum(s) * (1.0f / DM) + EPS);
#pragma unroll
        for (int j = 0; j < 8; ++j) { const int c = 4 * lane + 256 * j; const f32x4 g = *(const f32x4*)(p.g_final + c); *(f32x4*)(p.out + (size_t)row * DM + c) = v[j] * rstd * g; }
    }
}

constexpr int LDS_BYTES = 147456;
__global__ void __launch_bounds__(512, 2) fwd(Params p) {
    extern __shared__ __attribute__((aligned(16))) unsigned char lds_raw[];
    LAS unsigned char* lds = (LAS unsigned char*)lds_raw;
    const int tid = threadIdx.x, lane = tid & 63, wave = tid >> 6, G = gridDim.x;
    const int gw = blockIdx.x * 8 + wave, ngw = G * 8, gt = blockIdx.x * 512 + tid, ngt = G * 512;
    if (tid < 64) ((LAS unsigned*)(lds + LDSCTL_OFF))[tid] = 0u;
    __syncthreads();
    unsigned* ctl = (unsigned*)(p.ws + WS_CTL);
    const XcdBarrier bar = xcd_barrier_post(ctl + CW_BAR, (volatile LAS unsigned*)(lds + LDSCTL_OFF));

    phase_convert(p, gw, ngw, lane);
    for (int vb = blockIdx.x; vb < 192; vb += G) phase_ada_partial(p, lds + LDS_ADA, vb);
    xcd_barrier(bar);
    { pg8::FoldSched S{(const char*)(p.ws + WS_WPOOL), (const char*)(p.ws + WS_WINNAT), G, (int)blockIdx.x};
      pg8::EpiBf16 E{(bf16_t*)(p.ws + WS_WIN), DM, nullptr};
      pg8::gemm_phase<256, pg8::EpiBf16, pg8::FoldSched, true, true>(lds, S, E); }
    phase_mod_rest(p, gt, ngt);
    phase_norm1(p, lds, lane);
    xcd_barrier(bar);
    { pg8::DenseSched S{(const char*)(p.ws + WS_H1), (const char*)(p.ws + WS_WIN), DM, DM, NT / 256, DIN / 256, (NT / 256) * (DIN / 256), G, (int)blockIdx.x};
      pg8::EpiBf16 E{(bf16_t*)(p.ws + WS_PROJ), DIN, nullptr};
      pg8::gemm_phase<DM, pg8::EpiBf16, pg8::DenseSched, true, true>(lds, S, E); }
    xcd_barrier(bar);
    for (int u = blockIdx.x; u < 256; u += G) attn_unit(lds, (const bf16_t*)(p.ws + WS_PROJ), (bf16_t*)(p.ws + WS_MIX), p.sinks, u);
    phase_pool_win(p, gt, ngt);
    xcd_barrier(bar);
    { pg8::DenseSched S{(const char*)(p.ws + WS_MIX), (const char*)(p.ws + WS_WOUT), DM, DM, NT / 256, DM / 256, (NT / 256) * (DM / 256), G, (int)blockIdx.x};
      pg8::EpiDelta E{(bf16_t*)(p.ws + WS_DELTA), (const float*)(p.ws + WS_MOD)};
      pg8::gemm_phase<DM, pg8::EpiDelta, pg8::DenseSched, true, true>(lds, S, E); }
    xcd_barrier(bar);
    phase_norm2_router(p, lds, lane);
    xcd_barrier(bar);
    phase_offsets_assign(p, lds, gt, ngt);
    xcd_barrier(bar);
    { const int nmt = *(const int*)(p.ws + WS_ROUTE + RT_NMT);
      pg8::GuSched S{(const char*)(p.ws + WS_H2), (const char*)(p.ws + WS_WGU), (const int*)(p.ws + WS_ROUTE + RT_TILEE), (const int*)(p.ws + WS_ROUTE + RT_ROWTOK), nmt * 4, G, (int)blockIdx.x};
      pg8::EpiGu E{(bf16_t*)(p.ws + WS_HID)};
      pg8::gemm_phase<DM, pg8::EpiGu, pg8::GuSched, true, true>(lds, S, E); }
    xcd_barrier(bar);
    { const int nmt = *(const int*)(p.ws + WS_ROUTE + RT_NMT);
      pg8::DownSched S{(const char*)(p.ws + WS_HID), (const char*)(p.ws + WS_WD), (const int*)(p.ws + WS_ROUTE + RT_TILEE), nmt * 8, G, (int)blockIdx.x};
      pg8::EpiBf16 E{(bf16_t*)(p.ws + WS_Y), DM, nullptr};
      pg8::gemm_phase<DE, pg8::EpiBf16, pg8::DownSched, true, true>(lds, S, E); }
    xcd_barrier(bar);
    phase_final(p, gw, ngw, lane);
}

extern "C" void kernel_launch(void* const* d_in, const int* in_sizes, int n_in, void* d_out, int out_size, void* d_ws, size_t ws_size, hipStream_t stream) {
    static int grid = 0;
    if (grid == 0) {
        if (n_in != 19 || in_sizes[0] != NT * DM || out_size != NT * DM || ws_size < WS_END) { fprintf(stderr, "kernel_launch: unexpected shapes (n_in %d, in0 %d, out %d, ws %zu)\n", n_in, n_in > 0 ? in_sizes[0] : -1, out_size, ws_size); grid = -1; return; }
        if (hipFuncSetAttribute((const void*)fwd, hipFuncAttributeMaxDynamicSharedMemorySize, LDS_BYTES) != hipSuccess) { fprintf(stderr, "kernel_launch: hipFuncSetAttribute failed\n"); grid = -1; return; }
        int dev = 0, cus = 0, per_cu = 0;
        if (hipGetDevice(&dev) != hipSuccess || hipDeviceGetAttribute(&cus, hipDeviceAttributeMultiprocessorCount, dev) != hipSuccess) { grid = -1; return; }
        if (hipOccupancyMaxActiveBlocksPerMultiprocessor(&per_cu, (const void*)fwd, 512, LDS_BYTES) != hipSuccess || per_cu < 1) { fprintf(stderr, "kernel_launch: occupancy query says %d blocks per CU\n", per_cu); (void)hipGetLastError(); }
        grid = cus;
    }
    if (grid < 0) return;
    (void)hipMemsetAsync((char*)d_ws + WS_CTL, 0, 1 * MiB, stream);
    Params p{};
    const float** pf = (const float**)&p;
    for (int i = 0; i < 19; ++i) pf[i] = (const float*)d_in[i];
    p.out = (float*)d_out; p.ws = (unsigned char*)d_ws;
    hipLaunchKernelGGL(fwd, dim3(grid), dim3(512), LDS_BYTES, stream, p);
}
```

```cpp
#include <hip/hip_runtime.h>
#include <cstdio>
#include <cstdint>

#define LAS __attribute__((address_space(3)))
typedef unsigned short bf16_t;
typedef short bf16x8 __attribute__((ext_vector_type(8)));
typedef float f32x4 __attribute__((ext_vector_type(4)));
typedef float f32x16 __attribute__((ext_vector_type(16)));
typedef unsigned u32x4 __attribute__((ext_vector_type(4)));
typedef unsigned u32x2 __attribute__((ext_vector_type(2)));

constexpr int DM = 2048, NB = 4, SEQ = 4096, NT = NB * SEQ;
constexpr int DPOOL = 1024, DIN = 2304, QOFF = 1024, KOFF = 2048, VOFF = 2176;
constexpr int NE = 64, DE = 512, NMOD = 6;
constexpr int PMAX = 2 * NT + NE * 256;
constexpr int MAXMT = PMAX / 256;
constexpr float EPS = 1e-6f;
constexpr int ADA_KS = 32;

constexpr size_t MiB = 1u << 20;
constexpr size_t WS_CTL = 0;
constexpr size_t WS_MOD = 1 * MiB;
constexpr size_t WS_MODP = 2 * MiB;
constexpr size_t WS_WIN = 8 * MiB;
constexpr size_t WS_WOUT = 17 * MiB;
constexpr size_t WS_WPOOL = 25 * MiB;
constexpr size_t WS_WR = 26 * MiB;
constexpr size_t WS_ROUTE = 27 * MiB;
constexpr size_t WS_WINNAT = 28 * MiB;
constexpr size_t WS_WGU = 32 * MiB;
constexpr size_t WS_WD = 288 * MiB;
constexpr size_t WS_DELTA = 416 * MiB;
constexpr size_t WS_H1 = 544 * MiB;
constexpr size_t WS_PROJ = 608 * MiB;
constexpr size_t WS_Y = 544 * MiB;
constexpr size_t WS_MIX = 736 * MiB;
constexpr size_t WS_H2 = 736 * MiB;
constexpr size_t WS_HID = 802 * MiB;
constexpr size_t WS_END = 850 * MiB;
constexpr size_t RT_TOKE = 0;
constexpr size_t RT_TOKW = 128 * 1024;
constexpr size_t RT_TOKP = 256 * 1024;
constexpr size_t RT_ROWTOK = 384 * 1024;
constexpr size_t RT_TILEE = 640 * 1024;
constexpr size_t RT_PSTART = 644 * 1024;
constexpr size_t RT_NMT = 648 * 1024;
constexpr int CW_COUNTS = 64;
constexpr int CW_CURSOR = 192;

__device__ __forceinline__ unsigned cvt_pk_bf16(float lo, float hi) { unsigned r; asm volatile("v_cvt_pk_bf16_f32 %0, %1, %2" : "=v"(r) : "v"(lo), "v"(hi)); return r; }
__device__ __forceinline__ float bf_lo(unsigned w) { return __uint_as_float(w << 16); }
__device__ __forceinline__ float bf_hi(unsigned w) { return __uint_as_float(w & 0xffff0000u); }
__device__ __forceinline__ float wave_sum(float v) {
#pragma unroll
    for (int o = 1; o < 64; o <<= 1) v += __shfl_xor(v, o);
    return v;
}
__device__ __forceinline__ float fast_silu(float g) { return g * __builtin_amdgcn_rcpf(1.0f + __builtin_amdgcn_exp2f(-1.44269504089f * g)); }

namespace pg8 {
constexpr int BM = 256, BK = 64, HALF = 128, HTB = HALF * BK * 2, STAGE_BYTES = 8 * HTB, NXCD = 8, WGM = 8;
__host__ __device__ __forceinline__ int lds_byte(int r, int c) { const int st = (r >> 4) * 2 + (c >> 5), rr = r & 15, cc = c & 31, ob = rr * 64 + cc * 2; return st * 1024 + (ob ^ (((ob >> 9) & 1) << 5)); }
__host__ __device__ __forceinline__ void stage_rc(int b, int& R, int& C) { const int st = b / 1024, sb = b % 1024, swz = sb ^ (((sb >> 9) & 1) << 5); R = (st >> 1) * 16 + swz / 64; C = (st & 1) * 32 + (swz % 64) / 2; }
__host__ __device__ __forceinline__ int perm32(int rho) { const int n = rho >> 4, i = rho & 15; return 8 * (i >> 2) + 4 * n + (i & 3); }

struct Unit { int pm, pn, e; };

template <int K, class Epi, class Sched, bool ALIGN_EPI, bool SP2>
__device__ __forceinline__ void gemm_phase(LAS unsigned char* lds, const Sched& S, const Epi& E) {
    static_assert(K % 128 == 0 && K >= 256, "K");
    const int tid = threadIdx.x, wid = __builtin_amdgcn_readfirstlane(tid >> 6), lane = tid & 63, wr = wid >> 2, wc = wid & 3, fr = lane & 15, fq = lane >> 4;
    constexpr int nt = K / BK;
    int R0, C0, R1, C1; stage_rc(tid * 16, R0, C0); stage_rc(tid * 16 + 8192, R1, C1);
    const int Rb0 = Epi::PERM ? ((R0 & ~31) + perm32(R0 & 31)) : R0, Rb1 = Epi::PERM ? ((R1 & ~31) + perm32(R1 & 31)) : R1;
    const unsigned ldb2 = (unsigned)S.ldb() * 2u;
    unsigned voffB[2]; voffB[0] = (unsigned)Rb0 * ldb2 + (unsigned)C0 * 2u; voffB[1] = (unsigned)Rb1 * ldb2 + (unsigned)C1 * 2u;
    const size_t hstepB = (size_t)HALF * ldb2;
    constexpr size_t kstep = (size_t)(BK * 2);
    const unsigned ldsw = (unsigned)wid * 1024u;
    const int aoff = lds_byte(wr * 64 + fr, fq * 8), boff = lds_byte(wc * 32 + fr, fq * 8);
#define PG8_SA(b, h) (((b) * 2 + (h)) * HTB)
#define PG8_SB(b, h) ((4 + (b) * 2 + (h)) * HTB)
#define PG8_STAGE2(bufoff, gbase, v0, v1) do { \
        __builtin_amdgcn_global_load_lds((const unsigned*)((const char*)(gbase) + (v0)), (LAS unsigned*)(lds + (bufoff) + ldsw), 16, 0, 0); \
        __builtin_amdgcn_global_load_lds((const unsigned*)((const char*)(gbase) + (v1)), (LAS unsigned*)(lds + (bufoff) + ldsw + 8192), 16, 0, 0); } while (0)
#define PG8_STAGE_B(bufoff, gbase) PG8_STAGE2(bufoff, gbase, voffB[0], voffB[1])
#define PG8_LDA(dst, b, h) do { _Pragma("unroll") for (int m = 0; m < 4; ++m) _Pragma("unroll") for (int k = 0; k < 2; ++k) dst[m][k] = *(const LAS bf16x8*)(lds + PG8_SA(b, h) + aoff + m * 2048 + k * 1024); } while (0)
#define PG8_LDB(dst, b, h) do { _Pragma("unroll") for (int n = 0; n < 2; ++n) _Pragma("unroll") for (int k = 0; k < 2; ++k) dst[n][k] = *(const LAS bf16x8*)(lds + PG8_SB(b, h) + boff + n * 2048 + k * 1024); } while (0)
#define PG8_MMA(ai, bj, At, Bt) do { __builtin_amdgcn_s_setprio(1); _Pragma("unroll") for (int m = 0; m < 4; ++m) _Pragma("unroll") for (int n = 0; n < 2; ++n) _Pragma("unroll") for (int k = 0; k < 2; ++k) \
        acc[ai][bj][m][n] = __builtin_amdgcn_mfma_f32_16x16x32_bf16(Bt[n][k], At[m][k], acc[ai][bj][m][n], 0, 0, 0); __builtin_amdgcn_s_setprio(0); } while (0)
#define PG8_WAIT_V(n) asm volatile("s_waitcnt vmcnt(" #n ")" ::: "memory")
#define PG8_WAIT_L(n) asm volatile("s_waitcnt lgkmcnt(" #n ")" ::: "memory")
#define PG8_BAR __builtin_amdgcn_s_barrier()
#define PG8_SCHED __builtin_amdgcn_sched_barrier(0)
    Unit cur, nxt; int ui = 0;
    if (!S.next(0, cur)) return;
    f32x4 acc[2][2][4][2];
#pragma unroll
    for (int a = 0; a < 2; ++a)
#pragma unroll
        for (int b = 0; b < 2; ++b)
#pragma unroll
            for (int m = 0; m < 4; ++m)
#pragma unroll
                for (int n = 0; n < 2; ++n) acc[a][b][m][n] = (f32x4){0.f, 0.f, 0.f, 0.f};
    bf16x8 At[4][2], B0[2][2], B1[2][2];
    unsigned ca[4], na[4];
    S.a_offs(cur, R0, C0, R1, C1, ca);
    const char* cA = S.a_base(cur); const char* cB = S.b_base(cur);
    if constexpr (SP2) {
        PG8_STAGE_B(PG8_SB(0, 0), cB); PG8_STAGE_B(PG8_SB(0, 1), cB + hstepB); PG8_STAGE2(PG8_SA(0, 0), cA, ca[0], ca[1]); PG8_STAGE2(PG8_SA(0, 1), cA, ca[2], ca[3]);
        if (wr == 1) PG8_BAR;
        PG8_WAIT_V(2); PG8_BAR;
        PG8_STAGE_B(PG8_SB(1, 0), cB + kstep); PG8_STAGE2(PG8_SA(1, 0), cA + kstep, ca[0], ca[1]); PG8_STAGE_B(PG8_SB(1, 1), cB + hstepB + kstep);
        PG8_WAIT_V(6); PG8_BAR;
    } else {
        PG8_STAGE_B(PG8_SB(0, 0), cB); PG8_STAGE2(PG8_SA(0, 0), cA, ca[0], ca[1]); PG8_STAGE_B(PG8_SB(0, 1), cB + hstepB); PG8_STAGE2(PG8_SA(0, 1), cA, ca[2], ca[3]);
        if (wr == 1) PG8_BAR;
        PG8_WAIT_V(4); PG8_BAR;
        PG8_STAGE_B(PG8_SB(1, 0), cB + kstep); PG8_STAGE2(PG8_SA(1, 0), cA + kstep, ca[0], ca[1]); PG8_STAGE_B(PG8_SB(1, 1), cB + hstepB + kstep);
        PG8_WAIT_V(6); PG8_BAR;
    }
    for (;;) {
        const bool has_next = S.next(ui + 1, nxt);
        const char* nA = has_next ? S.a_base(nxt) : cA; const char* nB = has_next ? S.b_base(nxt) : cB;
        if (has_next) S.a_offs(nxt, R0, C0, R1, C1, na); else { na[0] = ca[0]; na[1] = ca[1]; na[2] = ca[2]; na[3] = ca[3]; }
        if constexpr (Sched::GATHER) asm volatile("" : "+v"(na[0]), "+v"(na[1]), "+v"(na[2]), "+v"(na[3]));
#pragma unroll 1
        for (int t = 0; t < nt; t += 2) {
            const bool last = (t == nt - 2);
            const char* a1 = cA + (size_t)(t + 1) * kstep;
            const char* a2 = last ? nA : cA + (size_t)(t + 2) * kstep; const char* b2 = last ? nB : cB + (size_t)(t + 2) * kstep;
            const char* a3 = a2 + kstep; const char* b3 = b2 + kstep;
            unsigned xa[4];
#pragma unroll
            for (int q = 0; q < 4; ++q) xa[q] = last ? na[q] : ca[q];
            if constexpr (SP2) {
            PG8_LDB(B0, 0, 0); PG8_LDB(B1, 0, 1); PG8_SCHED; PG8_LDA(At, 0, 0); PG8_STAGE2(PG8_SA(1, 1), a1, ca[2], ca[3]);
            PG8_WAIT_V(8); PG8_WAIT_L(0); PG8_BAR; PG8_MMA(0, 0, At, B0); PG8_MMA(0, 1, At, B1); PG8_BAR; PG8_SCHED;
            PG8_LDA(At, 0, 1); PG8_STAGE_B(PG8_SB(0, 0), b2); PG8_STAGE_B(PG8_SB(0, 1), b2 + hstepB); PG8_STAGE2(PG8_SA(0, 0), a2, xa[0], xa[1]);
            PG8_WAIT_V(8); PG8_WAIT_L(0); PG8_BAR; PG8_MMA(1, 0, At, B0); PG8_MMA(1, 1, At, B1); PG8_BAR; PG8_SCHED;
            PG8_LDB(B0, 1, 0); PG8_LDB(B1, 1, 1); PG8_SCHED; PG8_LDA(At, 1, 0); PG8_STAGE2(PG8_SA(0, 1), a2, xa[2], xa[3]);
            PG8_WAIT_V(8); PG8_WAIT_L(0); PG8_BAR; PG8_MMA(0, 0, At, B0); PG8_MMA(0, 1, At, B1); PG8_BAR; PG8_SCHED;
            PG8_LDA(At, 1, 1); PG8_STAGE_B(PG8_SB(1, 0), b3); PG8_STAGE_B(PG8_SB(1, 1), b3 + hstepB); PG8_STAGE2(PG8_SA(1, 0), a3, xa[0], xa[1]);
            PG8_WAIT_V(8); PG8_WAIT_L(0); PG8_BAR; PG8_MMA(1, 0, At, B0); PG8_MMA(1, 1, At, B1); PG8_BAR; PG8_SCHED;
            } else {
            PG8_LDB(B0, 0, 0); PG8_SCHED; PG8_LDA(At, 0, 0); PG8_STAGE2(PG8_SA(1, 1), a1, ca[2], ca[3]);
            PG8_WAIT_L(8); PG8_BAR; PG8_WAIT_L(0); PG8_MMA(0, 0, At, B0); PG8_BAR; PG8_SCHED;
            PG8_LDB(B1, 0, 1); PG8_STAGE_B(PG8_SB(0, 0), b2);
            PG8_BAR; PG8_WAIT_L(0); PG8_MMA(0, 1, At, B1); PG8_BAR;
            PG8_LDA(At, 0, 1); PG8_STAGE2(PG8_SA(0, 0), a2, xa[0], xa[1]);
            PG8_BAR; PG8_WAIT_L(0); PG8_MMA(1, 0, At, B0); PG8_BAR; PG8_SCHED;
            PG8_STAGE_B(PG8_SB(0, 1), b2 + hstepB);
            PG8_WAIT_V(6); PG8_BAR; PG8_MMA(1, 1, At, B1); PG8_BAR;
            PG8_LDB(B0, 1, 0); PG8_SCHED; PG8_LDA(At, 1, 0); PG8_STAGE2(PG8_SA(0, 1), a2, xa[2], xa[3]);
            PG8_WAIT_L(8); PG8_BAR; PG8_WAIT_L(0); PG8_MMA(0, 0, At, B0); PG8_BAR; PG8_SCHED;
            PG8_LDB(B1, 1, 1); PG8_STAGE_B(PG8_SB(1, 0), b3);
            PG8_BAR; PG8_WAIT_L(0); PG8_MMA(0, 1, At, B1); PG8_BAR;
            PG8_LDA(At, 1, 1); PG8_STAGE2(PG8_SA(1, 0), a3, xa[0], xa[1]);
            PG8_BAR; PG8_WAIT_L(0); PG8_MMA(1, 0, At, B0); PG8_BAR; PG8_SCHED;
            PG8_STAGE_B(PG8_SB(1, 1), b3 + hstepB);
            PG8_WAIT_V(6); PG8_BAR; PG8_MMA(1, 1, At, B1); PG8_BAR;
            }
        }
        if constexpr (ALIGN_EPI) { if (wr == 0) PG8_BAR; }
        E(acc, cur, wr, wc, fr, fq);
        if (!has_next) break;
#pragma unroll
        for (int a = 0; a < 2; ++a)
#pragma unroll
            for (int b = 0; b < 2; ++b)
#pragma unroll
                for (int m = 0; m < 4; ++m)
#pragma unroll
                    for (int n = 0; n < 2; ++n) acc[a][b][m][n] = (f32x4){0.f, 0.f, 0.f, 0.f};
        cur = nxt; cA = nA; cB = nB; ++ui;
#pragma unroll
        for (int q = 0; q < 4; ++q) ca[q] = na[q];
        if constexpr (ALIGN_EPI) { if (wr == 1) PG8_BAR; }
    }
    PG8_WAIT_V(0);
    if constexpr (!ALIGN_EPI) { if (wr == 0) PG8_BAR; }
    PG8_BAR;
#undef PG8_SA
#undef PG8_SB
#undef PG8_STAGE2
#undef PG8_STAGE_B
#undef PG8_LDA
#undef PG8_LDB
#undef PG8_MMA
#undef PG8_WAIT_V
#undef PG8_WAIT_L
#undef PG8_BAR
#undef PG8_SCHED
}

struct DenseSched {
    static constexpr bool GATHER = false;
    const char* A; const char* Bt; int lda_, ldb_, nM, nN, nwg, G, c;
    __device__ __forceinline__ int ldb() const { return ldb_; }
    __device__ __forceinline__ bool next(int i, Unit& u) const {
        const long L = (long)i * G + c; if (L >= nwg) return false;
        int wgid = (int)L; { const int q = nwg / NXCD, r = nwg % NXCD, xcd = wgid % NXCD, off = wgid / NXCD; wgid = (xcd < r ? xcd * (q + 1) : r * (q + 1) + (xcd - r) * q) + off; }
        const int nig = WGM * nN, gid = wgid / nig, fm = gid * WGM, gsz = (nM - fm) < WGM ? (nM - fm) : WGM;
        u.pm = fm + ((wgid % nig) % gsz); u.pn = (wgid % nig) / gsz; u.e = 0; return true;
    }
    __device__ __forceinline__ const char* a_base(const Unit& u) const { return A + (size_t)u.pm * BM * lda_ * 2; }
    __device__ __forceinline__ const char* b_base(const Unit& u) const { return Bt + (size_t)u.pn * BM * ldb_ * 2; }
    __device__ __forceinline__ void a_offs(const Unit&, int R0, int C0, int R1, int C1, unsigned (&o)[4]) const {
        o[0] = (unsigned)(R0 * lda_ + C0) * 2u; o[1] = (unsigned)(R1 * lda_ + C1) * 2u; o[2] = (unsigned)((R0 + HALF) * lda_ + C0) * 2u; o[3] = (unsigned)((R1 + HALF) * lda_ + C1) * 2u;
    }
};
struct FoldSched {
    static constexpr bool GATHER = false;
    const char* A; const char* Bt; int G, c;
    __device__ __forceinline__ int ldb() const { return DPOOL; }
    __device__ __forceinline__ bool next(int i, Unit& u) const { const int L = i * G + c; if (L >= 32) return false; u.pm = L >> 3; u.pn = L & 7; u.e = 0; return true; }
    __device__ __forceinline__ const char* a_base(const Unit& u) const { return A + (size_t)u.pm * 256 * 256 * 2; }
    __device__ __forceinline__ const char* b_base(const Unit& u) const { return Bt + ((size_t)u.pn * BM * DPOOL + (size_t)u.pm * 256) * 2; }
    __device__ __forceinline__ void a_offs(const Unit&, int R0, int C0, int R1, int C1, unsigned (&o)[4]) const {
        o[0] = (unsigned)(R0 * 256 + C0) * 2u; o[1] = (unsigned)(R1 * 256 + C1) * 2u; o[2] = (unsigned)((R0 + HALF) * 256 + C0) * 2u; o[3] = (unsigned)((R1 + HALF) * 256 + C1) * 2u;
    }
};
struct GuSched {
    static constexpr bool GATHER = true;
    const char* H2; const char* W; const int* tile_e; const int* row_tok; int n_units, G, c;
    __device__ __forceinline__ int ldb() const { return DM; }
    __device__ __forceinline__ bool next(int i, Unit& u) const { const int L = i * G + c; if (L >= n_units) return false; u.pm = L >> 2; u.pn = L & 3; u.e = tile_e[u.pm]; return true; }
    __device__ __forceinline__ const char* a_base(const Unit&) const { return H2; }
    __device__ __forceinline__ const char* b_base(const Unit& u) const { return W + ((size_t)u.e * 1024 + (size_t)u.pn * 256) * DM * 2; }
    __device__ __forceinline__ void a_offs(const Unit& u, int R0, int C0, int R1, int C1, unsigned (&o)[4]) const {
        const int* rt = row_tok + u.pm * BM;
        const int t0 = rt[R0], t1 = rt[R1], t2 = rt[R0 + HALF], t3 = rt[R1 + HALF];
        o[0] = (unsigned)(t0 * DM + C0) * 2u; o[1] = (unsigned)(t1 * DM + C1) * 2u; o[2] = (unsigned)(t2 * DM + C0) * 2u; o[3] = (unsigned)(t3 * DM + C1) * 2u;
    }
};
struct DownSched {
    static constexpr bool GATHER = false;
    const char* A; const char* W; const int* tile_e; int n_units, G, c;
    __device__ __forceinline__ int ldb() const { return DE; }
    __device__ __forceinline__ bool next(int i, Unit& u) const { const int L = i * G + c; if (L >= n_units) return false; u.pm = L >> 3; u.pn = L & 7; u.e = tile_e[u.pm]; return true; }
    __device__ __forceinline__ const char* a_base(const Unit& u) const { return A + (size_t)u.pm * BM * DE * 2; }
    __device__ __forceinline__ const char* b_base(const Unit& u) const { return W + ((size_t)u.e * DM + (size_t)u.pn * 256) * DE * 2; }
    __device__ __forceinline__ void a_offs(const Unit&, int R0, int C0, int R1, int C1, unsigned (&o)[4]) const {
        o[0] = (unsigned)(R0 * DE + C0) * 2u; o[1] = (unsigned)(R1 * DE + C1) * 2u; o[2] = (unsigned)((R0 + HALF) * DE + C0) * 2u; o[3] = (unsigned)((R1 + HALF) * DE + C1) * 2u;
    }
};

struct EpiBf16 {
    static constexpr bool PERM = true;
    bf16_t* O; int ldc; const float* cscale;
    __device__ __forceinline__ void operator()(const f32x4 (&acc)[2][2][4][2], const Unit& u, int wr, int wc, int fr, int fq) const {
        const int row0 = u.pm * BM + wr * 64 + fr, col0 = u.pn * BM + wc * 32 + 8 * fq;
#pragma unroll
        for (int bj = 0; bj < 2; ++bj) {
            f32x4 s0 = {1.f, 1.f, 1.f, 1.f}, s1 = s0;
            if (cscale) { s0 = *(const f32x4*)(cscale + col0 + bj * HALF); s1 = *(const f32x4*)(cscale + col0 + bj * HALF + 4); }
#pragma unroll
            for (int ai = 0; ai < 2; ++ai)
#pragma unroll
                for (int m = 0; m < 4; ++m) { bf16_t* rowp = O + (size_t)(row0 + ai * HALF + m * 16) * ldc + col0;
                    const f32x4 v0 = acc[ai][bj][m][0] * s0, v1 = acc[ai][bj][m][1] * s1;
                    u32x4 w; w.x = cvt_pk_bf16(v0[0], v0[1]); w.y = cvt_pk_bf16(v0[2], v0[3]); w.z = cvt_pk_bf16(v1[0], v1[1]); w.w = cvt_pk_bf16(v1[2], v1[3]);
                    *(u32x4*)(rowp + bj * HALF) = w; }
            asm volatile("" ::: "memory");
        }
    }
};
struct EpiDelta {
    static constexpr bool PERM = true;
    bf16_t* O; const float* mod;
    __device__ __forceinline__ void operator()(const f32x4 (&acc)[2][2][4][2], const Unit& u, int wr, int wc, int fr, int fq) const {
        const int row0 = u.pm * BM + wr * 64 + fr, col0 = u.pn * BM + wc * 32 + 8 * fq;
        const float* gt = mod + (size_t)((u.pm * BM) / SEQ) * (NMOD * DM) + 2 * DM;
#pragma unroll
        for (int bj = 0; bj < 2; ++bj) {
            const f32x4 s0 = *(const f32x4*)(gt + col0 + bj * HALF), s1 = *(const f32x4*)(gt + col0 + bj * HALF + 4);
#pragma unroll
            for (int ai = 0; ai < 2; ++ai)
#pragma unroll
                for (int m = 0; m < 4; ++m) { bf16_t* rowp = O + (size_t)(row0 + ai * HALF + m * 16) * DM + col0;
                    const f32x4 v0 = acc[ai][bj][m][0] * s0, v1 = acc[ai][bj][m][1] * s1;
                    u32x4 w; w.x = cvt_pk_bf16(v0[0], v0[1]); w.y = cvt_pk_bf16(v0[2], v0[3]); w.z = cvt_pk_bf16(v1[0], v1[1]); w.w = cvt_pk_bf16(v1[2], v1[3]);
                    *(u32x4*)(rowp + bj * HALF) = w; }
            asm volatile("" ::: "memory");
        }
    }
};
struct EpiGu {
    static constexpr bool PERM = true;
    bf16_t* Hid;
    __device__ __forceinline__ void operator()(const f32x4 (&acc)[2][2][4][2], const Unit& u, int wr, int wc, int fr, int fq) const {
        const int row0 = u.pm * BM + wr * 64 + fr, col0 = u.pn * HALF + wc * 32 + 8 * fq;
#pragma unroll
        for (int ai = 0; ai < 2; ++ai)
#pragma unroll
            for (int m = 0; m < 4; ++m) { bf16_t* rowp = Hid + (size_t)(row0 + ai * HALF + m * 16) * DE + col0;
                const f32x4 g0 = acc[ai][0][m][0], g1 = acc[ai][0][m][1], u0 = acc[ai][1][m][0], u1 = acc[ai][1][m][1];
                float o[8];
#pragma unroll
                for (int j = 0; j < 4; ++j) { o[j] = fast_silu(g0[j]) * u0[j]; o[4 + j] = fast_silu(g1[j]) * u1[j]; }
                u32x4 w; w.x = cvt_pk_bf16(o[0], o[1]); w.y = cvt_pk_bf16(o[2], o[3]); w.z = cvt_pk_bf16(o[4], o[5]); w.w = cvt_pk_bf16(o[6], o[7]);
                *(u32x4*)rowp = w; }
    }
};
}


#define XB_TMO      128
#define XB_XCNT(j)  (256  + 64 * (j))
#define XB_XSUB(j)  (1280 + 64 * (j))
#define XB_XGEN(j)  (2304 + 64 * (j))
#define XB_TOP      3328
#define XB_TOPGEN   3392
#define XCD_BAR_WORDS 3456
#define XB_SPIN_CAP (1u << 18)
__device__ __forceinline__ unsigned xb_ld(unsigned* p)              { return __hip_atomic_load(p, __ATOMIC_RELAXED, __HIP_MEMORY_SCOPE_AGENT); }
__device__ __forceinline__ unsigned xb_add(unsigned* p, unsigned v) { return __hip_atomic_fetch_add(p, v, __ATOMIC_RELAXED, __HIP_MEMORY_SCOPE_AGENT); }
__device__ __forceinline__ unsigned xb_xcc_id() { return (unsigned)__builtin_amdgcn_s_getreg((3 << 11) | 20) & 0xFu; }
#define XB_SPIN(cond, bar) do { unsigned _sp = 0; while (cond) { __builtin_amdgcn_s_sleep(1); \
    if ((++_sp & 255u) == 0u) { if (xb_ld(&(bar)[XB_TMO])) break; if (_sp > XB_SPIN_CAP) { atomicAdd(&(bar)[XB_TMO], 1u); break; } } } } while (0)
struct XcdBarrier { unsigned* bar; unsigned x; volatile LAS unsigned* st; };
__device__ __forceinline__ XcdBarrier xcd_barrier_post(unsigned* bar, volatile LAS unsigned* st) {
    XcdBarrier b; b.bar = bar; b.x = xb_xcc_id(); b.st = st;
    if (threadIdx.x == 0) (void)xb_add(&bar[XB_XCNT(b.x)], 1u);
    return b;
}
__device__ __forceinline__ void xcd_barrier_complete(unsigned* bar, unsigned x, unsigned& nloc, unsigned& nx) {
    const unsigned G = gridDim.x * gridDim.y * gridDim.z;
    unsigned sum, cnt, mine, sp = 0u;
    for (;;) {
        sum = 0u; cnt = 0u; mine = 0u;
#pragma unroll
        for (unsigned j = 0; j < 16; ++j) { const unsigned c = xb_ld(&bar[XB_XCNT(j)]); sum += c; cnt += (c > 0u) ? 1u : 0u; mine = (j == x) ? c : mine; }
        if (sum == G) break;
        __builtin_amdgcn_s_sleep(1);
        if ((++sp & 255u) == 0u) { if (xb_ld(&bar[XB_TMO])) break; if (sp > XB_SPIN_CAP) { atomicAdd(&bar[XB_TMO], 1u); break; } }
    }
    nloc = mine > 0u ? mine : 1u; nx = cnt > 0u ? cnt : 1u;
}
__device__ __forceinline__ void xcd_barrier(const XcdBarrier& b) {
    asm volatile("s_waitcnt vmcnt(0)" ::: "memory");
    __syncthreads();
    if (threadIdx.x == 0) {
        unsigned* bar = b.bar;
        __builtin_amdgcn_s_waitcnt(0);
        unsigned nloc = b.st[0], nx = b.st[1];
        if (nloc == 0u) { xcd_barrier_complete(bar, b.x, nloc, nx); b.st[0] = nloc; b.st[1] = nx; }
        const unsigned old = xb_add(&bar[XB_XSUB(b.x)], 1u);
        const unsigned gen = old / nloc;
        if (old + 1u == (gen + 1u) * nloc) {
            __builtin_amdgcn_fence(__ATOMIC_RELEASE, "agent");
            asm volatile("s_waitcnt vmcnt(0)" ::: "memory");
            const unsigned og = xb_add(&bar[XB_TOP], 1u);
            const unsigned tg = og / nx;
            if (og + 1u == (tg + 1u) * nx) xb_add(&bar[XB_TOPGEN], 1u);
            else XB_SPIN(xb_ld(&bar[XB_TOPGEN]) == tg, bar);
            __builtin_amdgcn_fence(__ATOMIC_ACQUIRE, "agent");
            xb_add(&bar[XB_XGEN(b.x)], 1u);
            asm volatile("s_waitcnt vmcnt(0)" ::: "memory");
        } else {
            XB_SPIN(xb_ld(&bar[XB_XGEN(b.x)]) == gen, bar);
            __builtin_amdgcn_fence(__ATOMIC_ACQUIRE, "agent");
            asm volatile("s_waitcnt vmcnt(0)" ::: "memory");
        }
    }
    __syncthreads();
}
constexpr int CW_BAR = 4096;
constexpr int LDSCTL_OFF = 131072;
constexpr int LDS_PSTART = LDSCTL_OFF + 256, LDS_ADA = LDSCTL_OFF + 1024;

struct ConvItem { const float* src; bf16_t* dst; int ldw, ldo; };
__device__ __forceinline__ void conv_load(const ConvItem& it, int lane, f32x4 (&v)[8]) {
    const int c = lane & 7, q = lane >> 3; const float* src = it.src + (size_t)(8 * q) * it.ldw + 4 * c;
#pragma unroll
    for (int j = 0; j < 8; ++j) v[j] = __builtin_nontemporal_load((const f32x4*)(src + (size_t)j * it.ldw));
}
__device__ __forceinline__ void conv_store(const ConvItem& it, int lane, const f32x4 (&v)[8]) {
    const int c = lane & 7, q = lane >> 3;
#pragma unroll
    for (int i = 0; i < 4; ++i) { u32x4 o; o.x = cvt_pk_bf16(v[0][i], v[1][i]); o.y = cvt_pk_bf16(v[2][i], v[3][i]); o.z = cvt_pk_bf16(v[4][i], v[5][i]); o.w = cvt_pk_bf16(v[6][i], v[7][i]);
        *(u32x4*)(it.dst + (size_t)(4 * c + i) * it.ldo + 8 * q) = o; }
}

struct Params {
    const float *x, *c, *w_ada, *b_ada, *g1, *w_in, *w_pool, *pool_scale, *sinks, *w_out, *g2, *w_rg, *b_rg, *w_re, *b_re, *w_gate, *w_up, *w_down, *g_final;
    float* out; unsigned char* ws;
};

__device__ __forceinline__ ConvItem conv_decode(const Params& p, int r) {
    bf16_t* Win_t = (bf16_t*)(p.ws + WS_WIN); bf16_t* Wout_t = (bf16_t*)(p.ws + WS_WOUT); bf16_t* Wpool_t = (bf16_t*)(p.ws + WS_WPOOL);
    bf16_t* Wgu_t = (bf16_t*)(p.ws + WS_WGU); bf16_t* Wd_t = (bf16_t*)(p.ws + WS_WD);
    constexpr int I_IN = 32 * 40, I_OUT = 32 * 64, I_POOL = 4 * 4 * 8, I_G = NE * 512;
    if (r < I_IN) { const int kb = r / 40, nb = 32 + r % 40; return ConvItem{p.w_in + (size_t)(64 * kb) * DIN + 32 * nb, Win_t + (size_t)(32 * nb) * DM + 64 * kb, DIN, DM}; } r -= I_IN;
    if (r < I_POOL) { const int g = r / 32, q = r % 32, kb = q / 8, nb = q % 8;
        return ConvItem{p.w_pool + (size_t)g * 65536 + (size_t)(64 * kb) * 256 + 32 * nb, Wpool_t + (size_t)g * 65536 + (size_t)(32 * nb) * 256 + 64 * kb, 256, 256}; } r -= I_POOL;
    if (r < I_OUT) { const int kb = r / 64, nb = r % 64; return ConvItem{p.w_out + (size_t)(64 * kb) * DM + 32 * nb, Wout_t + (size_t)(32 * nb) * DM + 64 * kb, DM, DM}; } r -= I_OUT;
    if (r < 2 * I_G) { const int up = r >= I_G; if (up) r -= I_G; const int e = r / 512, q = r % 512, kb = q / 16, nb = q % 16; const int n0 = 32 * nb;
        const float* W = (up ? p.w_up : p.w_gate) + (size_t)e * DM * DE + (size_t)(64 * kb) * DE + n0;
        const int drow = (n0 >> 7) * 256 + (n0 & 127) + (up ? 128 : 0);
        return ConvItem{W, Wgu_t + ((size_t)e * 1024 + drow) * DM + 64 * kb, DE, DM}; } r -= 2 * I_G;
    { const int e = r / 512, q = r % 512, kb = q / 64, nb = q % 64;
      return ConvItem{p.w_down + (size_t)e * DE * DM + (size_t)(64 * kb) * DM + 32 * nb, Wd_t + ((size_t)e * DM + 32 * nb) * DE + 64 * kb, DM, DE}; }
}
constexpr int CONV_NITEMS = 32 * 40 + 4 * 4 * 8 + 32 * 64 + 3 * NE * 512;
constexpr int CONV_SMALL_ITEMS = 32 * 40 + 4 * 4 * 8;
constexpr int NGEMM_INPROJ = 192;
constexpr int NGEMM_OUTPROJ = 128;
constexpr int CONV_P2_END = CONV_SMALL_ITEMS + 26000;
__device__ __forceinline__ void convert_items(const Params& p, int lo, int hi, int gw, int ngw, int lane) {
    for (int it = lo + gw; it < hi; it += 2 * ngw) {
        const int it2 = it + ngw; const bool two = it2 < hi;
        const ConvItem A = conv_decode(p, it), B = conv_decode(p, two ? it2 : it);
        f32x4 va[8], vb[8];
        conv_load(A, lane, va); if (two) conv_load(B, lane, vb);
        conv_store(A, lane, va); if (two) conv_store(B, lane, vb);
    }
}
__device__ __forceinline__ void phase_convert(const Params& p, int gw, int ngw, int lane) {
    bf16_t* Wr_t = (bf16_t*)(p.ws + WS_WR); bf16_t* Win_nat = (bf16_t*)(p.ws + WS_WINNAT);
    convert_items(p, 0, CONV_SMALL_ITEMS, gw, ngw, lane);
    const int gt = gw * 64 + lane, ngt = ngw * 64;
    for (int i = gt; i < DM * DPOOL / 8; i += ngt) { const int k = i >> 7, c8 = i & 127; const f32x4 a = *(const f32x4*)(p.w_in + (size_t)k * DIN + c8 * 8), b = *(const f32x4*)(p.w_in + (size_t)k * DIN + c8 * 8 + 4);
        u32x4 o; o.x = cvt_pk_bf16(a[0], a[1]); o.y = cvt_pk_bf16(a[2], a[3]); o.z = cvt_pk_bf16(b[0], b[1]); o.w = cvt_pk_bf16(b[2], b[3]); *(u32x4*)(Win_nat + (size_t)k * DPOOL + c8 * 8) = o; }
    for (int i = gt; i < 80 * DM; i += ngt) { const int n = i / DM, k = i % DM; float v = 0.f; if (n < 8) v = p.w_rg[(size_t)k * 8 + n]; else if (n < 72) v = p.w_re[(size_t)k * 64 + (n - 8)];
        Wr_t[i] = (bf16_t)(cvt_pk_bf16(v, 0.f) & 0xffffu); }
}

__device__ __forceinline__ void phase_ada_partial(const Params& p, LAS unsigned char* lds, int vb) {
    LAS float* sc = (LAS float*)lds;
    const int tid = threadIdx.x; const int g = vb * 512 + tid; const int ks = vb / 6, col4 = g % 3072;
    __syncthreads();
    if (tid < 256) { const int b = tid >> 6, k = tid & 63; const float cv = p.c[b * DM + ks * 64 + k]; sc[tid] = cv / (1.0f + __expf(-cv)); }
    __syncthreads();
    f32x4 a0 = {0, 0, 0, 0}, a1 = a0, a2 = a0, a3 = a0;
    const float* W = p.w_ada + (size_t)(ks * 64) * (NMOD * DM) + col4 * 4;
#pragma unroll 8
    for (int k = 0; k < 64; ++k) { const f32x4 w = *(const f32x4*)(W + (size_t)k * (NMOD * DM)); a0 += w * sc[k]; a1 += w * sc[64 + k]; a2 += w * sc[128 + k]; a3 += w * sc[192 + k]; }
    float* mp = (float*)(p.ws + WS_MODP) + (size_t)ks * 4 * (NMOD * DM) + col4 * 4;
    *(f32x4*)(mp) = a0; *(f32x4*)(mp + NMOD * DM) = a1; *(f32x4*)(mp + 2 * NMOD * DM) = a2; *(f32x4*)(mp + 3 * NMOD * DM) = a3;
}
__device__ __forceinline__ void phase_mod_rest(const Params& p, int gt, int ngt) {
    const float* mp = (const float*)(p.ws + WS_MODP); float* mod = (float*)(p.ws + WS_MOD);
    for (int i = gt; i < 4 * 4 * DM; i += ngt) { const int b = i / (4 * DM), j = 2 * DM + i % (4 * DM); float s = p.b_ada[j];
        for (int ks = 0; ks < ADA_KS; ++ks) s += mp[((size_t)ks * 4 + b) * (NMOD * DM) + j];
        mod[(size_t)b * NMOD * DM + j] = s; }
}
__device__ __forceinline__ void norm_rows2_load(const float* xr0, const float* xr1, int lane, f32x4 (&v0)[8], f32x4 (&v1)[8]) {
#pragma unroll
    for (int j = 0; j < 8; ++j) { v0[j] = *(const f32x4*)(xr0 + 4 * lane + 256 * j); v1[j] = *(const f32x4*)(xr1 + 4 * lane + 256 * j); }
}
__device__ __forceinline__ float ssq8(const f32x4 (&v)[8]) { float s = 0.f;
#pragma unroll
    for (int j = 0; j < 8; ++j) s += (v[j][0] * v[j][0] + v[j][1] * v[j][1]) + (v[j][2] * v[j][2] + v[j][3] * v[j][3]);
    return s; }
__device__ __forceinline__ void phase_norm1(const Params& p, LAS unsigned char* lds, int lane) {
    const float* mp = (const float*)(p.ws + WS_MODP); bf16_t* h1 = (bf16_t*)(p.ws + WS_H1);
    LAS float* tab = (LAS float*)lds;
    const int tid = threadIdx.x, wave = tid >> 6;
    for (int chunk = blockIdx.x; chunk < NT / 64; chunk += gridDim.x) {
        const int b = chunk >> 6;
        __syncthreads();
        for (int i = tid; i < 2 * DM; i += 512) { float part[ADA_KS];
#pragma unroll
            for (int ks = 0; ks < ADA_KS; ++ks) part[ks] = mp[((size_t)ks * 4 + b) * (NMOD * DM) + i];
            float s = p.b_ada[i];
#pragma unroll
            for (int ks = 0; ks < ADA_KS; ++ks) s += part[ks];
            tab[i] = (i >= DM) ? p.g1[i - DM] * (1.0f + s) : s; }
        __syncthreads();
        for (int rr = wave * 8; rr < wave * 8 + 8; rr += 2) { const int row = chunk * 64 + rr;
            f32x4 v0[8], v1[8]; norm_rows2_load(p.x + (size_t)row * DM, p.x + (size_t)(row + 1) * DM, lane, v0, v1);
            const float r0 = 1.0f / sqrtf(wave_sum(ssq8(v0)) * (1.0f / DM) + EPS), r1 = 1.0f / sqrtf(wave_sum(ssq8(v1)) * (1.0f / DM) + EPS);
#pragma unroll
            for (int j = 0; j < 8; ++j) { const int c = 4 * lane + 256 * j; const f32x4 g = *(const LAS f32x4*)(tab + DM + c), sft = *(const LAS f32x4*)(tab + c);
                const f32x4 o0 = v0[j] * r0 * g + sft, o1 = v1[j] * r1 * g + sft;
                u32x2 w0; w0.x = cvt_pk_bf16(o0[0], o0[1]); w0.y = cvt_pk_bf16(o0[2], o0[3]); *(u32x2*)(h1 + (size_t)row * DM + c) = w0;
                u32x2 w1; w1.x = cvt_pk_bf16(o1[0], o1[1]); w1.y = cvt_pk_bf16(o1[2], o1[3]); *(u32x2*)(h1 + (size_t)(row + 1) * DM + c) = w1; } }
    }
}

constexpr int ATT_KP = 144, ATT_VP = 520;
__device__ __forceinline__ void attn_unit(LAS unsigned char* lds, const bf16_t* proj, bf16_t* mix, const float* sinks, int unit) {
    const int tid = threadIdx.x, wid = tid >> 6, lane = tid & 63, l31 = lane & 31, hh = lane >> 5;
    const int kvh = unit & 1, nb = (unit >> 1) & 31, b = unit >> 6;
    const int t0 = b * SEQ + nb * 128;
    LAS unsigned char* Ks = lds; LAS unsigned char* Vt = lds + 256 * ATT_KP;
    __syncthreads();
    for (int c = tid; c < 2048; c += 512) { const int j = c >> 3, ch = c & 7; u32x4 v = {0u, 0u, 0u, 0u};
        if (nb > 0 || j >= 128) v = *(const u32x4*)(proj + (size_t)(t0 - 128 + j) * DIN + KOFF + kvh * 64 + ch * 8);
        *(LAS u32x4*)(Ks + j * ATT_KP + ch * 16) = v; }
    for (int c = tid; c < 1024; c += 512) { const int jp = c & 127, ch = c >> 7; u32x4 v0 = {0u, 0u, 0u, 0u}, v1 = v0;
        if (nb > 0 || jp >= 64) { const bf16_t* vp = proj + (size_t)(t0 - 128 + 2 * jp) * DIN + VOFF + kvh * 64 + ch * 8; v0 = *(const u32x4*)vp; v1 = *(const u32x4*)(vp + DIN); }
#pragma unroll
        for (int e = 0; e < 8; ++e) { const unsigned lo = (v0[e >> 1] >> (16 * (e & 1))) & 0xffffu, hi = (v1[e >> 1] >> (16 * (e & 1))) & 0xffffu;
            *(LAS unsigned*)(Vt + (ch * 8 + e) * ATT_VP + jp * 4) = lo | (hi << 16); } }
    __syncthreads();
    const int hq = kvh * 8 + wid; const float sink2 = sinks[hq] * 1.44269504089f; const float sc2 = 0.125f * 1.44269504089f;
    for (int r = 0; r < 4; ++r) {
        const bf16_t* qp = proj + (size_t)(t0 + 32 * r + l31) * DIN + QOFF + hq * 64 + 8 * hh;
        bf16x8 qf[4];
#pragma unroll
        for (int s = 0; s < 4; ++s) qf[s] = *(const bf16x8*)(qp + 16 * s);
        f32x16 sc[5];
#pragma unroll
        for (int tt = 0; tt < 5; ++tt) { f32x16 a;
#pragma unroll
            for (int i = 0; i < 16; ++i) a[i] = 0.f;
#pragma unroll
            for (int s = 0; s < 4; ++s) { const bf16x8 kf = *(const LAS bf16x8*)(Ks + (32 * (r + tt) + l31) * ATT_KP + (16 * s + 8 * hh) * 2); a = __builtin_amdgcn_mfma_f32_32x32x16_bf16(kf, qf[s], a, 0, 0, 0); }
            sc[tt] = a; }
        float mx = sink2;
#pragma unroll
        for (int tt = 0; tt < 5; ++tt)
#pragma unroll
            for (int i = 0; i < 16; ++i) { const int keyrow = (i & 3) + 8 * (i >> 2) + 4 * hh; bool masked = false;
                if (tt == 0) masked = keyrow <= l31; if (tt == 4) masked = keyrow > l31; if (nb == 0 && r + tt < 4) masked = true;
                const float v = masked ? -1e30f : sc[tt][i] * sc2; sc[tt][i] = v; mx = fmaxf(mx, v); }
        mx = fmaxf(mx, __shfl_xor(mx, 32));
        float sum = 0.f;
#pragma unroll
        for (int tt = 0; tt < 5; ++tt)
#pragma unroll
            for (int i = 0; i < 16; ++i) { const float pv = __builtin_amdgcn_exp2f(sc[tt][i] - mx); sc[tt][i] = pv; sum += pv; }
        sum += __shfl_xor(sum, 32); sum += __builtin_amdgcn_exp2f(sink2 - mx);
        const float inv = 1.0f / sum;
        f32x16 o0, o1;
#pragma unroll
        for (int i = 0; i < 16; ++i) { o0[i] = 0.f; o1[i] = 0.f; }
#pragma unroll
        for (int tt = 0; tt < 5; ++tt)
#pragma unroll
            for (int s2 = 0; s2 < 2; ++s2) {
                u32x4 pw; pw.x = cvt_pk_bf16(sc[tt][8 * s2 + 0], sc[tt][8 * s2 + 1]); pw.y = cvt_pk_bf16(sc[tt][8 * s2 + 2], sc[tt][8 * s2 + 3]);
                pw.z = cvt_pk_bf16(sc[tt][8 * s2 + 4], sc[tt][8 * s2 + 5]); pw.w = cvt_pk_bf16(sc[tt][8 * s2 + 6], sc[tt][8 * s2 + 7]);
                const bf16x8 pb = __builtin_bit_cast(bf16x8, pw);
                const int kb = (32 * (r + tt) + 16 * s2 + 4 * hh) * 2;
                { const u32x2 lo = *(const LAS u32x2*)(Vt + l31 * ATT_VP + kb), hi = *(const LAS u32x2*)(Vt + l31 * ATT_VP + kb + 16);
                  const u32x4 vv = {lo.x, lo.y, hi.x, hi.y}; o0 = __builtin_amdgcn_mfma_f32_32x32x16_bf16(__builtin_bit_cast(bf16x8, vv), pb, o0, 0, 0, 0); }
                { const u32x2 lo = *(const LAS u32x2*)(Vt + (32 + l31) * ATT_VP + kb), hi = *(const LAS u32x2*)(Vt + (32 + l31) * ATT_VP + kb + 16);
                  const u32x4 vv = {lo.x, lo.y, hi.x, hi.y}; o1 = __builtin_amdgcn_mfma_f32_32x32x16_bf16(__builtin_bit_cast(bf16x8, vv), pb, o1, 0, 0, 0); }
            }
        bf16_t* op = mix + (size_t)(t0 + 32 * r + l31) * DM + DPOOL + hq * 64 + 4 * hh;
#pragma unroll
        for (int g = 0; g < 4; ++g) {
            u32x2 w0; w0.x = cvt_pk_bf16(o0[4 * g] * inv, o0[4 * g + 1] * inv); w0.y = cvt_pk_bf16(o0[4 * g + 2] * inv, o0[4 * g + 3] * inv); *(u32x2*)(op + 8 * g) = w0;
            u32x2 w1; w1.x = cvt_pk_bf16(o1[4 * g] * inv, o1[4 * g + 1] * inv); w1.y = cvt_pk_bf16(o1[4 * g + 2] * inv, o1[4 * g + 3] * inv); *(u32x2*)(op + 32 + 8 * g) = w1; }
    }
}

__device__ __forceinline__ void phase_pool_win(const Params& p, int gt, int ngt) {
    const bf16_t* proj = (const bf16_t*)(p.ws + WS_PROJ); bf16_t* mix = (bf16_t*)(p.ws + WS_MIX);
    for (int task = gt; task < (NT / 16) * 128; task += ngt) {
        const int r0 = (task >> 7) * 16, c8 = task & 127, tt0 = r0 & (SEQ - 1); const int w = 2 << (c8 >> 5);
        const bf16_t* zp = proj + (size_t)r0 * DIN + c8 * 8;
        const f32x4 sa = *(const f32x4*)(p.pool_scale + c8 * 8), sb = *(const f32x4*)(p.pool_scale + c8 * 8 + 4);
        float s[8] = {0, 0, 0, 0, 0, 0, 0, 0};
        for (int i = 1; i < w; ++i) if (tt0 - i >= 0) { const u32x4 v = *(const u32x4*)(zp - (ptrdiff_t)i * DIN);
#pragma unroll
            for (int q = 0; q < 4; ++q) { s[2 * q] += bf_lo(v[q]); s[2 * q + 1] += bf_hi(v[q]); } }
        for (int t = 0; t < 16; ++t) {
            const u32x4 v = *(const u32x4*)(zp + (size_t)t * DIN); float cur[8];
#pragma unroll
            for (int q = 0; q < 4; ++q) { cur[2 * q] = bf_lo(v[q]); cur[2 * q + 1] = bf_hi(v[q]); s[2 * q] += cur[2 * q]; s[2 * q + 1] += cur[2 * q + 1]; }
            const int nwin = (tt0 + t + 1 < w) ? tt0 + t + 1 : w; const float rn = 1.0f / (float)nwin;
            u32x4 o; o.x = cvt_pk_bf16((s[0] * rn - cur[0]) * sa[0], (s[1] * rn - cur[1]) * sa[1]); o.y = cvt_pk_bf16((s[2] * rn - cur[2]) * sa[2], (s[3] * rn - cur[3]) * sa[3]);
            o.z = cvt_pk_bf16((s[4] * rn - cur[4]) * sb[0], (s[5] * rn - cur[5]) * sb[1]); o.w = cvt_pk_bf16((s[6] * rn - cur[6]) * sb[2], (s[7] * rn - cur[7]) * sb[3]);
            *(u32x4*)(mix + (size_t)(r0 + t) * DM + c8 * 8) = o;
            if (tt0 + t - (w - 1) >= 0) { const u32x4 ov = *(const u32x4*)(zp + (ptrdiff_t)(t - (w - 1)) * DIN);
#pragma unroll
                for (int q = 0; q < 4; ++q) { s[2 * q] -= bf_lo(ov[q]); s[2 * q + 1] -= bf_hi(ov[q]); } }
        }
    }
}

__device__ __forceinline__ void phase_norm2_router(const Params& p, LAS unsigned char* lds, int lane, bool do_count = true) {
    const float* mod = (const float*)(p.ws + WS_MOD); const bf16_t* delta = (const bf16_t*)(p.ws + WS_DELTA);
    bf16_t* h2 = (bf16_t*)(p.ws + WS_H2); const bf16_t* Wr_t = (const bf16_t*)(p.ws + WS_WR);
    int* tok_e = (int*)(p.ws + WS_ROUTE + RT_TOKE); float* tok_w = (float*)(p.ws + WS_ROUTE + RT_TOKW); unsigned* ctl = (unsigned*)(p.ws + WS_CTL);
    LAS float* tab = (LAS float*)lds;
    LAS float* plog = (LAS float*)(lds + 16384);
    const int tid = threadIdx.x, wave = tid >> 6, fr = lane & 15, fq = lane >> 4;
    if (blockIdx.x == 0 && tid < 256) *(u32x4*)(h2 + (size_t)NT * DM + tid * 8) = (u32x4){0u, 0u, 0u, 0u};
    for (int chunk = blockIdx.x; chunk < NT / 64; chunk += gridDim.x) {
        const int b = chunk >> 6; const float* sh = mod + (size_t)b * NMOD * DM + 3 * DM; const float* scp = sh + DM;
        __syncthreads();
        for (int i = tid; i < DM; i += 512) { tab[i] = p.g2[i] * (1.0f + scp[i]); tab[DM + i] = sh[i]; }
        __syncthreads();
        for (int rr = wave * 8; rr < wave * 8 + 8; rr += 2) { const int row = chunk * 64 + rr;
            f32x4 v0[8], v1[8]; norm_rows2_load(p.x + (size_t)row * DM, p.x + (size_t)(row + 1) * DM, lane, v0, v1);
            const bf16_t* dr = delta + (size_t)row * DM;
#pragma unroll
            for (int j = 0; j < 8; ++j) { const int c = 4 * lane + 256 * j; const u32x2 d0 = *(const u32x2*)(dr + c), d1 = *(const u32x2*)(dr + DM + c);
                v0[j][0] += bf_lo(d0.x); v0[j][1] += bf_hi(d0.x); v0[j][2] += bf_lo(d0.y); v0[j][3] += bf_hi(d0.y);
                v1[j][0] += bf_lo(d1.x); v1[j][1] += bf_hi(d1.x); v1[j][2] += bf_lo(d1.y); v1[j][3] += bf_hi(d1.y); }
            const float r0 = 1.0f / sqrtf(wave_sum(ssq8(v0)) * (1.0f / DM) + EPS), r1 = 1.0f / sqrtf(wave_sum(ssq8(v1)) * (1.0f / DM) + EPS);
#pragma unroll
            for (int j = 0; j < 8; ++j) { const int c = 4 * lane + 256 * j; const f32x4 g = *(const LAS f32x4*)(tab + c), sft = *(const LAS f32x4*)(tab + DM + c);
                const f32x4 o0 = v0[j] * r0 * g + sft, o1 = v1[j] * r1 * g + sft;
                u32x2 w0; w0.x = cvt_pk_bf16(o0[0], o0[1]); w0.y = cvt_pk_bf16(o0[2], o0[3]); *(u32x2*)(h2 + (size_t)row * DM + c) = w0;
                u32x2 w1; w1.x = cvt_pk_bf16(o1[0], o1[1]); w1.y = cvt_pk_bf16(o1[2], o1[3]); *(u32x2*)(h2 + (size_t)(row + 1) * DM + c) = w1; } }
        asm volatile("s_waitcnt vmcnt(0)" ::: "memory");
        __syncthreads();
        { const int g = wave & 3, kh = wave >> 2; const int r0 = chunk * 64 + 16 * g;
          f32x4 acc[5];
#pragma unroll
          for (int n = 0; n < 5; ++n) acc[n] = (f32x4){0.f, 0.f, 0.f, 0.f};
          const bf16_t* ap = h2 + (size_t)(r0 + fr) * DM + kh * 1024 + 8 * fq; const bf16_t* bp = Wr_t + (size_t)fr * DM + kh * 1024 + 8 * fq;
#pragma unroll 8
          for (int k = 0; k < 1024; k += 32) { const bf16x8 af = *(const bf16x8*)(ap + k);
#pragma unroll
              for (int n = 0; n < 5; ++n) { const bf16x8 bf = *(const bf16x8*)(bp + (size_t)n * 16 * DM + k); acc[n] = __builtin_amdgcn_mfma_f32_16x16x32_bf16(af, bf, acc[n], 0, 0, 0); } }
          LAS float* lg = plog + wave * (16 * 80);
#pragma unroll
          for (int n = 0; n < 5; ++n)
#pragma unroll
              for (int j = 0; j < 4; ++j) lg[(4 * fq + j) * 80 + 16 * n + fr] = acc[n][j]; }
        __syncthreads();
        if (tid < 64) { const int g = tid >> 4, r = tid & 15; const LAS float* L0 = plog + g * (16 * 80) + r * 80; const LAS float* L1 = L0 + 4 * (16 * 80); const int row = chunk * 64 + tid;
            float gl[8]; float gm = -3.0e38f; int gs = 0;
#pragma unroll
            for (int i = 0; i < 8; ++i) { gl[i] = (L0[i] + L1[i]) + p.b_rg[i]; if (gl[i] > gm) { gm = gl[i]; gs = i; } }
            float den = 0.f;
#pragma unroll
            for (int i = 0; i < 8; ++i) den += __expf(gl[i] - gm);
            const float pg = 1.0f / den;
            float l1 = -3.0e38f, l2 = -3.0e38f; int i1 = 0, i2 = 0;
            for (int i = 0; i < 8; ++i) { const float v = (L0[8 + gs * 8 + i] + L1[8 + gs * 8 + i]) + p.b_re[gs * 8 + i];
                if (v > l1) { l2 = l1; i2 = i1; l1 = v; i1 = i; } else if (v > l2) { l2 = v; i2 = i; } }
            const float e2 = __expf(l2 - l1), w1 = pg / (1.0f + e2), w2 = pg * e2 / (1.0f + e2);
            const int ea = gs * 8 + i1, eb = gs * 8 + i2;
            tok_e[2 * row] = ea; tok_e[2 * row + 1] = eb; tok_w[2 * row] = w1; tok_w[2 * row + 1] = w2;
            if (do_count) { atomicAdd(&ctl[CW_COUNTS + ea], 1u); atomicAdd(&ctl[CW_COUNTS + eb], 1u); } }
    }
}

__device__ __forceinline__ void phase_offsets_assign(const Params& p, LAS unsigned char* lds, int gt, int ngt) {
    unsigned* ctl = (unsigned*)(p.ws + WS_CTL); const int tid = threadIdx.x;
    int* tile_e = (int*)(p.ws + WS_ROUTE + RT_TILEE); int* nmt = (int*)(p.ws + WS_ROUTE + RT_NMT); int* row_tok = (int*)(p.ws + WS_ROUTE + RT_ROWTOK);
    const int* tok_e = (const int*)(p.ws + WS_ROUTE + RT_TOKE); int* tok_p = (int*)(p.ws + WS_ROUTE + RT_TOKP);
    LAS int* ps_l = (LAS int*)(lds + LDS_PSTART);
    if (tid < 64) {
        const int cnt = (int)__hip_atomic_load(&ctl[CW_COUNTS + tid], __ATOMIC_RELAXED, __HIP_MEMORY_SCOPE_AGENT); const int pc = (cnt + 255) / 256 * 256;
        int incl = pc;
#pragma unroll
        for (int o = 1; o < 64; o <<= 1) { const int v = __shfl_up(incl, o); if (tid >= o) incl += v; }
        const int ps = incl - pc; ps_l[tid] = ps;
        if (blockIdx.x == 0) {
            for (int i = 0; i < pc / 256; ++i) tile_e[ps / 256 + i] = tid;
            for (int i = cnt; i < pc; ++i) row_tok[ps + i] = NT;
            if (tid == 63) *nmt = incl / 256;
        }
    }
    __syncthreads();
    for (int a = gt; a < 2 * NT; a += ngt) { const int e = tok_e[a]; const int pos = ps_l[e] + (int)atomicAdd(&ctl[CW_CURSOR + e], 1u); row_tok[pos] = a >> 1; tok_p[a] = pos; }
}

__device__ __forceinline__ void final_row_load(const Params& p, int row, int lane, f32x4 (&v)[8]) {
    const float* mod = (const float*)(p.ws + WS_MOD); const bf16_t* delta = (const bf16_t*)(p.ws + WS_DELTA); const bf16_t* Y = (const bf16_t*)(p.ws + WS_Y);
    const int* tok_p = (const int*)(p.ws + WS_ROUTE + RT_TOKP); const float* tok_w = (const float*)(p.ws + WS_ROUTE + RT_TOKW);
    const int b = row / SEQ; const float* gt = mod + (size_t)b * NMOD * DM + 5 * DM; const float* xr = p.x + (size_t)row * DM; const bf16_t* dr = delta + (size_t)row * DM;
    const int p0 = tok_p[2 * row], p1 = tok_p[2 * row + 1]; const float w0 = tok_w[2 * row], w1 = tok_w[2 * row + 1];
    const bf16_t* y0 = Y + (size_t)p0 * DM; const bf16_t* y1 = Y + (size_t)p1 * DM;
#pragma unroll
    for (int j = 0; j < 8; ++j) { const int c = 4 * lane + 256 * j; const f32x4 xv = *(const f32x4*)(xr + c), g = *(const f32x4*)(gt + c);
        const u32x2 a = *(const u32x2*)(y0 + c), bb = *(const u32x2*)(y1 + c), dv = *(const u32x2*)(dr + c);
        v[j][0] = (xv[0] + bf_lo(dv.x)) + g[0] * (w0 * bf_lo(a.x) + w1 * bf_lo(bb.x)); v[j][1] = (xv[1] + bf_hi(dv.x)) + g[1] * (w0 * bf_hi(a.x) + w1 * bf_hi(bb.x));
        v[j][2] = (xv[2] + bf_lo(dv.y)) + g[2] * (w0 * bf_lo(a.y) + w1 * bf_lo(bb.y)); v[j][3] = (xv[3] + bf_hi(dv.y)) + g[3] * (w0 * bf_hi(a.y) + w1 * bf_hi(bb.y)); }
}
__device__ __forceinline__ void phase_final(const Params& p, int gw, int ngw, int lane) {
    for (int row = gw; row < NT; row += ngw) {
        f32x4 v0[8]; final_row_load(p, row, lane, v0);
        const float r0 = 1.0f / sqrtf(wave_sum(ssq8(v0)) * (1.0f / DM) + EPS);
#pragma unroll
        for (int j = 0; j < 8; ++j) { const int c = 4 * lane + 256 * j; const f32x4 g = *(const f32x4*)(p.g_final + c); *(f32x4*)(p.out + (size_t)row * DM + c) = v0[j] * r0 * g; }
    }
}

constexpr int LDS_BYTES = 147456;
__global__ void __launch_bounds__(512, 2) fwd(Params p) {
    extern __shared__ __attribute__((aligned(16))) unsigned char lds_raw[];
    LAS unsigned char* lds = (LAS unsigned char*)lds_raw;
    const int tid = threadIdx.x, lane = tid & 63, wave = tid >> 6, G = gridDim.x;
    const int gw = blockIdx.x * 8 + wave, ngw = G * 8, gt = blockIdx.x * 512 + tid, ngt = G * 512;
    const int vcu = (G % 8 == 0) ? ((int)blockIdx.x % 8) * (G / 8) + (int)blockIdx.x / 8 : (int)blockIdx.x;
    if (tid < 64) ((LAS unsigned*)(lds + LDSCTL_OFF))[tid] = 0u;
    __syncthreads();
    unsigned* ctl = (unsigned*)(p.ws + WS_CTL);
    const XcdBarrier bar = xcd_barrier_post(ctl + CW_BAR, (volatile LAS unsigned*)(lds + LDSCTL_OFF));

    phase_convert(p, gw, ngw, lane);
    for (int vb = blockIdx.x; vb < 192; vb += G) phase_ada_partial(p, lds + LDS_ADA, vb);
    xcd_barrier(bar);
    { pg8::FoldSched S{(const char*)(p.ws + WS_WPOOL), (const char*)(p.ws + WS_WINNAT), G, (int)blockIdx.x};
      pg8::EpiBf16 E{(bf16_t*)(p.ws + WS_WIN), DM, nullptr};
      pg8::gemm_phase<256, pg8::EpiBf16, pg8::FoldSched, true, true>(lds, S, E); }
    phase_mod_rest(p, gt, ngt);
    phase_norm1(p, lds, lane);
    xcd_barrier(bar);
    if (G > NGEMM_INPROJ) {
        if ((int)blockIdx.x < NGEMM_INPROJ) {
            pg8::DenseSched S{(const char*)(p.ws + WS_H1), (const char*)(p.ws + WS_WIN), DM, DM, NT / 256, DIN / 256, (NT / 256) * (DIN / 256), NGEMM_INPROJ, (int)blockIdx.x};
            pg8::EpiBf16 E{(bf16_t*)(p.ws + WS_PROJ), DIN, nullptr};
            pg8::gemm_phase<DM, pg8::EpiBf16, pg8::DenseSched, true, true>(lds, S, E);
        } else convert_items(p, CONV_SMALL_ITEMS, CONV_P2_END, ((int)blockIdx.x - NGEMM_INPROJ) * 8 + wave, (G - NGEMM_INPROJ) * 8, lane);
    } else {
        pg8::DenseSched S{(const char*)(p.ws + WS_H1), (const char*)(p.ws + WS_WIN), DM, DM, NT / 256, DIN / 256, (NT / 256) * (DIN / 256), G, (int)blockIdx.x};
        pg8::EpiBf16 E{(bf16_t*)(p.ws + WS_PROJ), DIN, nullptr};
        pg8::gemm_phase<DM, pg8::EpiBf16, pg8::DenseSched, true, true>(lds, S, E);
        convert_items(p, CONV_SMALL_ITEMS, CONV_P2_END, gw, ngw, lane);
    }
    xcd_barrier(bar);
    for (int u = blockIdx.x; u < 256; u += G) attn_unit(lds, (const bf16_t*)(p.ws + WS_PROJ), (bf16_t*)(p.ws + WS_MIX), p.sinks, u);
    phase_pool_win(p, gt, ngt);
    xcd_barrier(bar);
    if (G > NGEMM_OUTPROJ) {
        if ((int)blockIdx.x < NGEMM_OUTPROJ) {
            pg8::DenseSched S{(const char*)(p.ws + WS_MIX), (const char*)(p.ws + WS_WOUT), DM, DM, NT / 256, DM / 256, (NT / 256) * (DM / 256), NGEMM_OUTPROJ, (int)blockIdx.x};
            pg8::EpiDelta E{(bf16_t*)(p.ws + WS_DELTA), (const float*)(p.ws + WS_MOD)};
            pg8::gemm_phase<DM, pg8::EpiDelta, pg8::DenseSched, true, true>(lds, S, E);
        } else convert_items(p, CONV_P2_END, CONV_NITEMS, ((int)blockIdx.x - NGEMM_OUTPROJ) * 8 + wave, (G - NGEMM_OUTPROJ) * 8, lane);
    } else {
        pg8::DenseSched S{(const char*)(p.ws + WS_MIX), (const char*)(p.ws + WS_WOUT), DM, DM, NT / 256, DM / 256, (NT / 256) * (DM / 256), G, (int)blockIdx.x};
        pg8::EpiDelta E{(bf16_t*)(p.ws + WS_DELTA), (const float*)(p.ws + WS_MOD)};
        pg8::gemm_phase<DM, pg8::EpiDelta, pg8::DenseSched, true, true>(lds, S, E);
        convert_items(p, CONV_P2_END, CONV_NITEMS, gw, ngw, lane);
    }
    xcd_barrier(bar);
    phase_norm2_router(p, lds, lane);
    xcd_barrier(bar);
    phase_offsets_assign(p, lds, gt, ngt);
    xcd_barrier(bar);
    { const int nmt = *(const int*)(p.ws + WS_ROUTE + RT_NMT);
      pg8::GuSched S{(const char*)(p.ws + WS_H2), (const char*)(p.ws + WS_WGU), (const int*)(p.ws + WS_ROUTE + RT_TILEE), (const int*)(p.ws + WS_ROUTE + RT_ROWTOK), nmt * 4, G, vcu};
      pg8::EpiGu E{(bf16_t*)(p.ws + WS_HID)};
      pg8::gemm_phase<DM, pg8::EpiGu, pg8::GuSched, true, true>(lds, S, E); }
    xcd_barrier(bar);
    { const int nmt = *(const int*)(p.ws + WS_ROUTE + RT_NMT);
      pg8::DownSched S{(const char*)(p.ws + WS_HID), (const char*)(p.ws + WS_WD), (const int*)(p.ws + WS_ROUTE + RT_TILEE), nmt * 8, G, vcu};
      pg8::EpiBf16 E{(bf16_t*)(p.ws + WS_Y), DM, nullptr};
      pg8::gemm_phase<DE, pg8::EpiBf16, pg8::DownSched, true, true>(lds, S, E); }
    xcd_barrier(bar);
    phase_final(p, gw, ngw, lane);
}

extern "C" void kernel_launch(void* const* d_in, const int* in_sizes, int n_in, void* d_out, int out_size, void* d_ws, size_t ws_size, hipStream_t stream) {
    static int grid = 0;
    if (grid == 0) {
        if (n_in != 19 || in_sizes[0] != NT * DM || out_size != NT * DM || ws_size < WS_END) { fprintf(stderr, "kernel_launch: unexpected shapes (n_in %d, in0 %d, out %d, ws %zu)\n", n_in, n_in > 0 ? in_sizes[0] : -1, out_size, ws_size); grid = -1; return; }
        if (hipFuncSetAttribute((const void*)fwd, hipFuncAttributeMaxDynamicSharedMemorySize, LDS_BYTES) != hipSuccess) { fprintf(stderr, "kernel_launch: hipFuncSetAttribute failed\n"); grid = -1; return; }
        int dev = 0, cus = 0, per_cu = 0;
        if (hipGetDevice(&dev) != hipSuccess || hipDeviceGetAttribute(&cus, hipDeviceAttributeMultiprocessorCount, dev) != hipSuccess) { grid = -1; return; }
        if (hipOccupancyMaxActiveBlocksPerMultiprocessor(&per_cu, (const void*)fwd, 512, LDS_BYTES) != hipSuccess || per_cu < 1) { fprintf(stderr, "kernel_launch: occupancy query says %d blocks per CU\n", per_cu); (void)hipGetLastError(); }
        grid = cus;
    }
    if (grid < 0) return;
    (void)hipMemsetAsync((char*)d_ws + WS_CTL, 0, 1 * MiB, stream);
    Params p{};
    const float** pf = (const float**)&p;
    for (int i = 0; i < 19; ++i) pf[i] = (const float*)d_in[i];
    p.out = (float*)d_out; p.ws = (unsigned char*)d_ws;
    hipLaunchKernelGGL(fwd, dim3(grid), dim3(512), LDS_BYTES, stream, p);
}
```
